# Optimizing an MI355X kernel written in HIP

```python
import math
import jax, jax.numpy as jnp
from jax import lax
import numpy as np


D_MODEL = 1024
BATCH = 1
SEQ = 16384
DEPTH = 4
DEC_BATCH = 8
DEC_SEQ = 8192
PAST_LEN = 128

N_MIXERS = 2
HEAD_DIM = 128
N_Q_HEADS = D_MODEL // HEAD_DIM
N_KV_HEADS = 2
Q_PER_KV = N_Q_HEADS // N_KV_HEADS
QKV_DIM = (N_Q_HEADS + 2 * N_KV_HEADS) * HEAD_DIM
ROPE_THETA = 10000.0
Q_BLOCK = 128
GRID_W = 64
SSM_WIDTH = D_MODEL
GROUP_CH = 16
N_GROUPS = SSM_WIDTH // GROUP_CH
STATE_DIM = 64
DT_MIN = 0.001
DT_MAX = 0.1
D_FF = -(-8 * D_MODEL // (3 * 256)) * 256
N_ATTN_LAYERS = (DEPTH + 1) // 2
N_SSM_LAYERS = DEPTH // 2
EPS = 1e-6

kernel_name = 'bidir_hybrid_attn_s5_encoder'


def rmsnorm(x, gain):
    x32 = x.astype(jnp.float32)
    y = x32 * lax.rsqrt(jnp.mean(x32 * x32, axis=-1, keepdims=True) + EPS)
    return (y * gain.astype(jnp.float32)).astype(x.dtype)


def modulate(h, shift, scale):
    return h * (1.0 + scale[:, None, :]) + shift[:, None, :]


def axial_rope_angles(L):
    rows = L // GRID_W
    row = jnp.repeat(jnp.arange(rows), GRID_W).astype(jnp.float32)
    col = jnp.tile(jnp.arange(GRID_W), rows).astype(jnp.float32)
    n_freq = HEAD_DIM // 4
    inv = ROPE_THETA ** (-jnp.arange(n_freq, dtype=jnp.float32) / n_freq)
    return row[:, None] * inv, col[:, None] * inv


def rope_half(x, ang):
    x1, x2 = jnp.split(x, 2, axis=-1)
    cos = jnp.cos(ang)[None, :, None, :]
    sin = jnp.sin(ang)[None, :, None, :]
    return jnp.concatenate([x1 * cos - x2 * sin, x2 * cos + x1 * sin], axis=-1)


def apply_axial_rope(x, ang_r, ang_c):
    x32 = x.astype(jnp.float32)
    half = HEAD_DIM // 2
    out = jnp.concatenate([rope_half(x32[..., :half], ang_r), rope_half(x32[..., half:], ang_c)], axis=-1)
    return out.astype(x.dtype)


def attention_mixer(h, w_qkv, q_gain, k_gain, w_o, ang_r, ang_c):
    B, L, _ = h.shape
    qkv = h @ w_qkv
    q, k, v = jnp.split(qkv, [N_Q_HEADS * HEAD_DIM, (N_Q_HEADS + N_KV_HEADS) * HEAD_DIM], axis=-1)
    q = q.reshape(B, L, N_Q_HEADS, HEAD_DIM)
    k = k.reshape(B, L, N_KV_HEADS, HEAD_DIM)
    v = v.reshape(B, L, N_KV_HEADS, HEAD_DIM)
    q = apply_axial_rope(rmsnorm(q, q_gain), ang_r, ang_c)
    k = apply_axial_rope(rmsnorm(k, k_gain), ang_r, ang_c)
    nb = L // Q_BLOCK
    qb = q.reshape(B, nb, Q_BLOCK, N_KV_HEADS, Q_PER_KV, HEAD_DIM).transpose(1, 0, 2, 3, 4, 5)
    scale = HEAD_DIM ** -0.5

    def attend(q_blk):
        s = jnp.einsum('bqkgd,bskd->bkgqs', q_blk, k, preferred_element_type=jnp.float32) * scale
        p = jax.nn.softmax(s, axis=-1)
        return jnp.einsum('bkgqs,bskd->bqkgd', p.astype(v.dtype), v)

    o = lax.map(attend, qb)
    o = o.transpose(1, 0, 2, 3, 4, 5).reshape(B, L, N_Q_HEADS * HEAD_DIM)
    return o @ w_o


def complex_linear_combine(e1, e2):
    a1r, a1i, b1r, b1i = e1
    a2r, a2i, b2r, b2i = e2
    return (a2r * a1r - a2i * a1i,
            a2r * a1i + a2i * a1r,
            a2r * b1r - a2i * b1i + b2r,
            a2r * b1i + a2i * b1r + b2i)


def s5_direction(ug, a_re, a_im, log_dt, b_re, b_im, c_re, c_im, reverse):
    dt = jnp.exp(log_dt)[:, None]
    mag = jnp.exp(dt * a_re)
    ab_re = mag * jnp.cos(dt * a_im)
    ab_im = mag * jnp.sin(dt * a_im)
    den = a_re * a_re + a_im * a_im
    nr = ab_re - 1.0
    f_re = (nr * a_re + ab_im * a_im) / den
    f_im = (ab_im * a_re - nr * a_im) / den
    bb_re = f_re[..., None] * b_re - f_im[..., None] * b_im
    bb_im = f_re[..., None] * b_im + f_im[..., None] * b_re
    bu_re = jnp.einsum('lgh,gph->lgp', ug, bb_re)
    bu_im = jnp.einsum('lgh,gph->lgp', ug, bb_im)
    shape = bu_re.shape
    _, _, s_re, s_im = lax.associative_scan(
        complex_linear_combine,
        (jnp.broadcast_to(ab_re, shape), jnp.broadcast_to(ab_im, shape), bu_re, bu_im),
        axis=0, reverse=reverse)
    return jnp.einsum('ghp,lgp->lgh', c_re, s_re) - jnp.einsum('ghp,lgp->lgh', c_im, s_im)


def ssm_mixer(h, w_in, a_re, a_im, log_dt, b_re, b_im, c_re, c_im, d, w_glu):
    B, L, _ = h.shape
    f32 = jnp.float32
    u = (h @ w_in).astype(f32)

    def one_seq(u_seq):
        ug = u_seq.reshape(L, N_GROUPS, GROUP_CH)
        y = d.astype(f32) * u_seq
        for direction, reverse in ((0, False), (1, True)):
            y = y + s5_direction(ug, a_re[direction].astype(f32), a_im[direction].astype(f32),
                                 log_dt[direction].astype(f32), b_re[direction].astype(f32),
                                 b_im[direction].astype(f32), c_re[direction].astype(f32),
                                 c_im[direction].astype(f32), reverse).reshape(L, SSM_WIDTH)
        return y

    y = lax.map(one_seq, u)
    y = jax.nn.gelu(y).astype(h.dtype)
    val, gate = jnp.split(y @ w_glu, 2, axis=-1)
    return val * jax.nn.sigmoid(gate)


def swiglu(h, w_gu, w_down):
    g, up = jnp.split(h @ w_gu, 2, axis=-1)
    return (jax.nn.silu(g) * up) @ w_down


def trunk(x, c, norm_gain, w_mod, b_mod, attn_w_qkv, attn_q_gain, attn_k_gain, attn_w_o,
          ssm_w_in, ssm_a_re, ssm_a_im, ssm_log_dt, ssm_b_re, ssm_b_im, ssm_c_re, ssm_c_im,
          ssm_d, ssm_w_glu, ffn_w_gu, ffn_w_down, final_gain):
    L = x.shape[1]
    ang_r, ang_c = axial_rope_angles(L)
    c_act = jax.nn.silu(c)
    for i in range(DEPTH):
        mod = c_act @ w_mod[i] + b_mod[i]
        sh1, sc1, g1, sh2, sc2, g2 = jnp.split(mod, 6, axis=-1)
        h = modulate(rmsnorm(x, norm_gain[i, 0]), sh1, sc1)
        j = i // N_MIXERS
        if i % N_MIXERS == 0:
            m = attention_mixer(h, attn_w_qkv[j], attn_q_gain[j], attn_k_gain[j], attn_w_o[j], ang_r, ang_c)
        else:
            m = ssm_mixer(h, ssm_w_in[j], ssm_a_re[j], ssm_a_im[j], ssm_log_dt[j], ssm_b_re[j],
                          ssm_b_im[j], ssm_c_re[j], ssm_c_im[j], ssm_d[j], ssm_w_glu[j])
        x = x + g1[:, None, :] * m
        h = modulate(rmsnorm(x, norm_gain[i, 1]), sh2, sc2)
        x = x + g2[:, None, :] * swiglu(h, ffn_w_gu[i], ffn_w_down[i])
    return rmsnorm(x, final_gain)


def setup_inputs(seed: int = 0) -> dict:
    key = jax.random.key(seed)
    ks = jax.random.split(key, 24)
    f32 = jnp.float32

    def nrm(k, shape, scale):
        return jax.random.normal(k, shape, f32) * scale

    NA, NS = N_ATTN_LAYERS, N_SSM_LAYERS
    n_idx = jnp.arange(STATE_DIM, dtype=f32)
    return {
        'x_prompt': nrm(ks[0], (BATCH, SEQ, D_MODEL), 1.0),
        'x_sample': nrm(ks[1], (DEC_BATCH, DEC_SEQ, D_MODEL), 1.0),
        'c_prompt': nrm(ks[2], (BATCH, D_MODEL), 1.0),
        'c_sample': nrm(ks[3], (DEC_BATCH, D_MODEL), 1.0),
        'norm_gain': 1.0 + nrm(ks[4], (DEPTH, 2, D_MODEL), 0.02),
        'w_mod': nrm(ks[5], (DEPTH, D_MODEL, 6 * D_MODEL), 0.5 * D_MODEL ** -0.5),
        'b_mod': nrm(ks[6], (DEPTH, 6 * D_MODEL), 0.02),
        'attn_w_qkv': nrm(ks[7], (NA, D_MODEL, QKV_DIM), D_MODEL ** -0.5),
        'attn_q_gain': 1.0 + nrm(ks[8], (NA, HEAD_DIM), 0.02),
        'attn_k_gain': 1.0 + nrm(ks[9], (NA, HEAD_DIM), 0.02),
        'attn_w_o': nrm(ks[10], (NA, N_Q_HEADS * HEAD_DIM, D_MODEL), (N_Q_HEADS * HEAD_DIM) ** -0.5),
        'ssm_w_in': nrm(ks[11], (NS, D_MODEL, SSM_WIDTH), D_MODEL ** -0.5),
        'ssm_a_re': -0.5 + nrm(ks[12], (NS, 2, N_GROUPS, STATE_DIM), 0.01),
        'ssm_a_im': math.pi * n_idx + nrm(ks[13], (NS, 2, N_GROUPS, STATE_DIM), 0.01),
        'ssm_log_dt': jax.random.uniform(ks[14], (NS, 2, N_GROUPS), f32, math.log(DT_MIN), math.log(DT_MAX)),
        'ssm_b_re': nrm(ks[15], (NS, 2, N_GROUPS, STATE_DIM, GROUP_CH), (2 * GROUP_CH) ** -0.5),
        'ssm_b_im': nrm(ks[16], (NS, 2, N_GROUPS, STATE_DIM, GROUP_CH), (2 * GROUP_CH) ** -0.5),
        'ssm_c_re': nrm(ks[17], (NS, 2, N_GROUPS, GROUP_CH, STATE_DIM), STATE_DIM ** -0.5),
        'ssm_c_im': nrm(ks[18], (NS, 2, N_GROUPS, GROUP_CH, STATE_DIM), STATE_DIM ** -0.5),
        'ssm_d': nrm(ks[19], (NS, SSM_WIDTH), 1.0),
        'ssm_w_glu': nrm(ks[20], (NS, SSM_WIDTH, 2 * D_MODEL), SSM_WIDTH ** -0.5),
        'ffn_w_gu': nrm(ks[21], (DEPTH, D_MODEL, 2 * D_FF), D_MODEL ** -0.5),
        'ffn_w_down': nrm(ks[22], (DEPTH, D_FF, D_MODEL), D_FF ** -0.5),
        'final_gain': 1.0 + nrm(ks[23], (D_MODEL,), 0.02),
    }


def reference(x_prompt, x_sample, c_prompt, c_sample, norm_gain, w_mod, b_mod, attn_w_qkv,
              attn_q_gain, attn_k_gain, attn_w_o, ssm_w_in, ssm_a_re, ssm_a_im, ssm_log_dt,
              ssm_b_re, ssm_b_im, ssm_c_re, ssm_c_im, ssm_d, ssm_w_glu, ffn_w_gu, ffn_w_down,
              final_gain):
    def run(x, c):
        return trunk(x, c, norm_gain=norm_gain, w_mod=w_mod, b_mod=b_mod, attn_w_qkv=attn_w_qkv,
                     attn_q_gain=attn_q_gain, attn_k_gain=attn_k_gain, attn_w_o=attn_w_o,
                     ssm_w_in=ssm_w_in, ssm_a_re=ssm_a_re, ssm_a_im=ssm_a_im, ssm_log_dt=ssm_log_dt,
                     ssm_b_re=ssm_b_re, ssm_b_im=ssm_b_im, ssm_c_re=ssm_c_re, ssm_c_im=ssm_c_im,
                     ssm_d=ssm_d, ssm_w_glu=ssm_w_glu, ffn_w_gu=ffn_w_gu, ffn_w_down=ffn_w_down,
                     final_gain=final_gain)

    y_prompt = run(x_prompt, c_prompt)
    y_sample = run(x_sample, c_sample)
    return (y_prompt, y_sample)
```

```cpp
#include <hip/hip_runtime.h>
#include <hip/hip_bf16.h>
#include <hip/hip_cooperative_groups.h>
#include <cstdio>
#include <cstdint>
#include <cmath>
namespace cg = cooperative_groups;

constexpr int DM = 1024, LP = 16384, NSS = 8, LS = 8192, TT = LP + NSS * LS, NB = 9, DFF = 2816, NQKV = 1536;
constexpr int NCH = TT / 32;
constexpr float EPS = 1e-6f;
constexpr size_t MiB = 1u << 20;
constexpr size_t WS_MOD = 0, WS_LAM = 1 * MiB, WS_GM = 1 * MiB + 256 * 1024, WS_BQKV = 2 * MiB, WS_BU = 2 * MiB + 128 * 1024, WS_BGU = 2 * MiB + 256 * 1024, WS_RSS = 984 * MiB;
constexpr size_t WS_WQKV = 8 * MiB, WS_WO = 14 * MiB, WS_WIN = 18 * MiB, WS_WGLU = 22 * MiB, WS_WGU = 30 * MiB, WS_WDN = 74 * MiB;
constexpr size_t WS_SSM = 96 * MiB, WS_HA = 224 * MiB, WS_XB = 384 * MiB, WS_BIG = 544 * MiB;
constexpr size_t WS_QKV = WS_BIG, WS_ACT = WS_BIG, WS_A2 = WS_BIG, WS_E = WS_BIG + 240 * MiB, WS_HB = WS_BIG + 240 * MiB, WS_END = WS_BIG + 440 * MiB;
static_assert(WS_END == 984 * MiB && WS_RSS + 9ull * TT * 8 <= 1024 * MiB, "ws map");
constexpr size_t WS_NEED = 1024 * MiB;
constexpr size_t WS_BAR = 896 * 1024;
constexpr int LDS_BYTES = 147456, EPI_LDS_OFF = 131072;

__device__ __forceinline__ int lane_id_asm() { int l; asm volatile("v_mbcnt_lo_u32_b32 %0, -1, 0\n\tv_mbcnt_hi_u32_b32 %0, -1, %0" : "=v"(l)); return l; }

namespace pg8 {
#define PG8_LAS __attribute__((address_space(3)))
typedef unsigned short bf16_t;
typedef short bf16x8 __attribute__((ext_vector_type(8)));
typedef float f32x4 __attribute__((ext_vector_type(4)));
typedef unsigned u32x4 __attribute__((ext_vector_type(4)));
constexpr int BM = 256, BK = 64, HALF = 128, HTB = HALF * BK * 2  , STAGE_BYTES = 8 * HTB, NXCD = 8, WGM = 8;

__host__ __device__ __forceinline__ int lds_byte(int r, int c) { const int st = (r >> 4) * 2 + (c >> 5), rr = r & 15, cc = c & 31, ob = rr * 64 + cc * 2; return st * 1024 + (ob ^ (((ob >> 9) & 1) << 5)); }
__host__ __device__ __forceinline__ void stage_rc(int b, int& R, int& C) { const int st = b / 1024, sb = b % 1024, swz = sb ^ (((sb >> 9) & 1) << 5); R = (st >> 1) * 16 + swz / 64; C = (st & 1) * 32 + (swz % 64) / 2; }
__host__ __device__ __forceinline__ int perm32(int rho) { const int n = rho >> 4, i = rho & 15; return 8 * (i >> 2) + 4 * n + (i & 3); }

struct Unit { int pm, pn, gb; };
struct Gemm { const bf16_t* A; const bf16_t* Bt; int M, N, K; size_t strideA, strideB; int lda; };

struct Order {
    int nM, nN, nwg, nb, G, c;
    __device__ __forceinline__ void init(int M, int N, int nb_, int G_, int c_) { nM = M / BM; nN = N / BM; nwg = nM * nN; nb = nb_; G = G_; c = c_; asm volatile("" : "+s"(c)); }
    __device__ __forceinline__ bool next(int i, Unit& u) const {
        const long L = (long)i * G + c; if (L >= (long)nwg * nb) return false;
        u.gb = (int)(L / nwg); int wgid = (int)(L - (long)u.gb * nwg);
        { const int q = nwg / NXCD, r = nwg % NXCD, xcd = wgid % NXCD, off = wgid / NXCD; wgid = (xcd < r ? xcd * (q + 1) : r * (q + 1) + (xcd - r) * q) + off; }
        const int nig = WGM * nN, gid = wgid / nig, fm = gid * WGM, gsz = (nM - fm) < WGM ? (nM - fm) : WGM;
        u.pm = fm + ((wgid % nig) % gsz); u.pn = (wgid % nig) / gsz; return true;
    }
    __device__ __forceinline__ void a_ready(const Unit&) const {}
    __device__ __forceinline__ void done(const Unit&) const {}
};

__device__ __forceinline__ unsigned cvt_pk_bf16(float lo, float hi) { unsigned r; asm volatile("v_cvt_pk_bf16_f32 %0, %1, %2" : "=v"(r) : "v"(lo), "v"(hi)); return r; }
__device__ __forceinline__ float sigmoid_f(float x) { return __builtin_amdgcn_rcpf(1.0f + __builtin_amdgcn_exp2f(-1.4426950408889634f * x)); }
__device__ __forceinline__ float gelu_tanh_f(float x) { const float u = 0.7978845608028654f * (x + 0.044715f * x * x * x); return x * sigmoid_f(2.0f * u); }
__device__ __forceinline__ int batch_of_tile(int pm) { return pm < 64 ? 0 : 1 + ((pm - 64) >> 5); }
constexpr int XD = 1024, XNB_STRIDE = 6144, XT = 81920, XNCH = 2560, XDFF = 2816;

typedef unsigned long long rss_t;
__device__ __forceinline__ rss_t rss_fix(float ss) { return (rss_t)(ss * 1048576.0f + 0.5f); }
__device__ __forceinline__ float rstd_of(const rss_t* rss, size_t row) { return __builtin_amdgcn_rsqf((float)rss[row] * (1.0f / (1048576.0f * 1024.0f)) + 1e-6f); }
__device__ __forceinline__ float bperm_f(int srclane, float v) { return __builtin_bit_cast(float, __builtin_amdgcn_ds_bpermute(srclane << 2, __builtin_bit_cast(int, v))); }

typedef _Float16 h16x2 __attribute__((ext_vector_type(2)));
typedef float f32x2_t __attribute__((ext_vector_type(2)));
__device__ __forceinline__ unsigned cvt_h(float f) { unsigned h; asm volatile("v_cvt_f16_f32 %0, %1" : "=v"(h) : "v"(f)); return h; }
__device__ __forceinline__ float cvt_f(unsigned h) { float f; asm volatile("v_cvt_f32_f16 %0, %1" : "=v"(f) : "v"(h)); return f; }
__device__ __forceinline__ float cvt_f_hi(unsigned h) { float f; asm volatile("v_cvt_f32_f16_sdwa %0, %1 dst_sel:DWORD dst_unused:UNUSED_PAD src0_sel:WORD_1" : "=v"(f) : "v"(h)); return f; }
__device__ __forceinline__ unsigned pk_h2(float a, float b) { unsigned r; const unsigned ha = cvt_h(a), hb = cvt_h(b); asm volatile("v_pack_b32_f16 %0, %1, %2" : "=v"(r) : "v"(ha), "v"(hb)); return r; }
__device__ __forceinline__ void bf8_to_f32(const u32x4 w, f32x4& lo, f32x4& hi) {
    lo[0] = cvt_f(w.x); lo[1] = cvt_f_hi(w.x); lo[2] = cvt_f(w.y); lo[3] = cvt_f_hi(w.y); hi[0] = cvt_f(w.z); hi[1] = cvt_f_hi(w.z); hi[2] = cvt_f(w.w); hi[3] = cvt_f_hi(w.w);
}
__device__ __forceinline__ u32x4 f32_to_h8(const f32x4 v0, const f32x4 v1) { u32x4 w; w.x = pk_h2(v0[0], v0[1]); w.y = pk_h2(v0[2], v0[3]); w.z = pk_h2(v1[0], v1[1]); w.w = pk_h2(v1[2], v1[3]); return w; }
__device__ __forceinline__ u32x4 f32_to_bf8(const f32x4 v0, const f32x4 v1) { u32x4 w; w.x = cvt_pk_bf16(v0[0], v0[1]); w.y = cvt_pk_bf16(v0[2], v0[3]); w.z = cvt_pk_bf16(v1[0], v1[1]); w.w = cvt_pk_bf16(v1[2], v1[3]); return w; }
__device__ __forceinline__ f32x2_t sigmoid_pk(const f32x2_t x) { const f32x2_t a = x * (-1.4426950408889634f); f32x2_t e; e.x = __builtin_amdgcn_exp2f(a.x); e.y = __builtin_amdgcn_exp2f(a.y);
    const f32x2_t d = e + 1.0f; f32x2_t r; r.x = __builtin_amdgcn_rcpf(d.x); r.y = __builtin_amdgcn_rcpf(d.y); return r; }
__device__ __forceinline__ f32x2_t gelu_tanh_pk(const f32x2_t x) {
    const f32x2_t p = (x * x) * 0.044715f + 1.0f, a = (x * (-2.3022081985f)) * p; f32x2_t e; e.x = __builtin_amdgcn_exp2f(a.x); e.y = __builtin_amdgcn_exp2f(a.y);
    const f32x2_t d = e + 1.0f; f32x2_t r; r.x = __builtin_amdgcn_rcpf(d.x); r.y = __builtin_amdgcn_rcpf(d.y); return x * r; }
struct EpiRes {
    static constexpr bool PERM = true, AFTER_DRAIN = false, PREFETCH = false;
    bf16_t* x; const float* gate; const float* gm; bf16_t* HA; rss_t* rss;
    __device__ __forceinline__ void operator()(const f32x4 (&acc)[2][2][4][2], const Unit& u, int wr, int wc, int fr, int fq) const {
        const int b = batch_of_tile(u.pm), col0 = u.pn * BM + wc * 32 + 8 * fq, ln = fq * 16 + fr;
        const float* gp = gate + (size_t)b * XNB_STRIDE + col0; const float* mp = gm ? gm + (size_t)b * XD + col0 : nullptr;
        bf16_t* xb = x + ((size_t)((((u.pm * 8 + 2 * u.pn) * 2 + wr) * 4 + wc) * 8) * 64 + ln) * 8;
#pragma unroll
        for (int ai = 0; ai < 2; ++ai) {
            u32x4 xs[4][2];
#pragma unroll
            for (int m = 0; m < 4; ++m)
#pragma unroll
                for (int bj = 0; bj < 2; ++bj) xs[m][bj] = *(const u32x4*)(xb + (size_t)bj * 32768 + (ai * 4 + m) * 512);
            f32x4 gv[2][2], mv[2][2];
#pragma unroll
            for (int bj = 0; bj < 2; ++bj)
#pragma unroll
                for (int n = 0; n < 2; ++n) { gv[bj][n] = *(const f32x4*)(gp + bj * HALF + 4 * n); if (mp) mv[bj][n] = *(const f32x4*)(mp + bj * HALF + 4 * n); }
#pragma unroll
            for (int m = 0; m < 4; ++m) { const size_t row = (size_t)(u.pm * BM + ai * HALF + wr * 64 + m * 16 + fr); float ss = 0.f;
#pragma unroll
                for (int bj = 0; bj < 2; ++bj) {
                    f32x4 v0, v1; bf8_to_f32(xs[m][bj], v0, v1);
                    v0 = v0 + gv[bj][0] * acc[ai][bj][m][0]; v1 = v1 + gv[bj][1] * acc[ai][bj][m][1];
                    *(u32x4*)(xb + (size_t)bj * 32768 + (ai * 4 + m) * 512) = f32_to_h8(v0, v1);
                    ss += (v0[0] * v0[0] + v0[1] * v0[1]) + (v0[2] * v0[2] + v0[3] * v0[3]) + (v1[0] * v1[0] + v1[1] * v1[1]) + (v1[2] * v1[2] + v1[3] * v1[3]);
                    if (mp) *(u32x4*)(HA + row * XD + col0 + bj * HALF) = f32_to_bf8(v0 * mv[bj][0], v1 * mv[bj][1]); }
                ss += bperm_f(ln ^ 16, ss); ss += bperm_f(ln ^ 32, ss);
                if (fq == 0) atomicAdd(rss + row, rss_fix(ss)); }
            asm volatile("" ::: "memory"); }
    }
};
struct EpiGU {
    static constexpr bool PERM = true, AFTER_DRAIN = false, PREFETCH = false;
    bf16_t* act; const rss_t* rss; const float* bias;
    __device__ __forceinline__ void operator()(const f32x4 (&acc)[2][2][4][2], const Unit& u, int wr, int wc, int fr, int fq) const {
        const int b = batch_of_tile(u.pm), col0 = u.pn * HALF + wc * 32 + 8 * fq;
        const float* bp = bias + (size_t)b * 5632 + u.pn * BM + wc * 32 + 8 * fq;
        const f32x4 bg0 = *(const f32x4*)bp, bg1 = *(const f32x4*)(bp + 4), bu0 = *(const f32x4*)(bp + HALF), bu1 = *(const f32x4*)(bp + HALF + 4);
        float rsv[2][4];
#pragma unroll
        for (int ai = 0; ai < 2; ++ai)
#pragma unroll
            for (int m = 0; m < 4; ++m) rsv[ai][m] = rstd_of(rss, (size_t)(u.pm * BM + ai * HALF + wr * 64 + m * 16 + fr));
#pragma unroll
        for (int ai = 0; ai < 2; ++ai)
#pragma unroll
            for (int m = 0; m < 4; ++m) { const size_t row = (size_t)(u.pm * BM + ai * HALF + wr * 64 + m * 16 + fr); const float rs = rsv[ai][m];
                u32x4 w;
#pragma unroll
                for (int n = 0; n < 2; ++n)
#pragma unroll
                    for (int h = 0; h < 2; ++h) {
                        const f32x2_t ag = {acc[ai][0][m][n][2 * h], acc[ai][0][m][n][2 * h + 1]}, au = {acc[ai][1][m][n][2 * h], acc[ai][1][m][n][2 * h + 1]};
                        const f32x4 bgv = n ? bg1 : bg0, buv = n ? bu1 : bu0;
                        const f32x2_t bg = {bgv[2 * h], bgv[2 * h + 1]}, bu = {buv[2 * h], buv[2 * h + 1]};
                        const f32x2_t g = ag * rs + bg, up = au * rs + bu, ea = g * (-1.4426950408889634f);
                        f32x2_t ex; ex.x = __builtin_amdgcn_exp2f(ea.x); ex.y = __builtin_amdgcn_exp2f(ea.y);
                        const f32x2_t d = ex + 1.0f; f32x2_t rc; rc.x = __builtin_amdgcn_rcpf(d.x); rc.y = __builtin_amdgcn_rcpf(d.y);
                        const f32x2_t o = (g * up) * rc;
                        w[n * 2 + h] = cvt_pk_bf16(o.x, o.y); }
                __builtin_nontemporal_store(w, (u32x4*)(act + row * XDFF + col0)); }
    }
};
struct EpiGluRes {
    static constexpr bool PERM = true, AFTER_DRAIN = false, PREFETCH = false;
    bf16_t* x; const float* gate; const float* gm; bf16_t* HA; rss_t* rss;
    __device__ __forceinline__ void operator()(const f32x4 (&acc)[2][2][4][2], const Unit& u, int wr, int wc, int fr, int fq) const {
        const int b = batch_of_tile(u.pm), col0 = u.pn * HALF + wc * 32 + 8 * fq, ln = fq * 16 + fr;
        const float* gp = gate + (size_t)b * XNB_STRIDE + col0; const float* mp = gm + (size_t)b * XD + col0;
        bf16_t* xb = x + ((size_t)((((u.pm * 8 + u.pn) * 2 + wr) * 4 + wc) * 8) * 64 + ln) * 8;
        u32x4 xs[2][4];
#pragma unroll
        for (int ai = 0; ai < 2; ++ai)
#pragma unroll
            for (int m = 0; m < 4; ++m) xs[ai][m] = *(const u32x4*)(xb + (ai * 4 + m) * 512);
        const f32x4 g0 = *(const f32x4*)gp, g1 = *(const f32x4*)(gp + 4), m0 = *(const f32x4*)mp, m1 = *(const f32x4*)(mp + 4);
#pragma unroll
        for (int ai = 0; ai < 2; ++ai)
#pragma unroll
            for (int m = 0; m < 4; ++m) { const size_t row = (size_t)(u.pm * BM + ai * HALF + wr * 64 + m * 16 + fr);
                f32x4 v0, v1; bf8_to_f32(xs[ai][m], v0, v1);
#pragma unroll
                for (int h = 0; h < 2; ++h) {
                    const f32x2_t s0 = sigmoid_pk((f32x2_t){acc[ai][1][m][0][2 * h], acc[ai][1][m][0][2 * h + 1]}), s1 = sigmoid_pk((f32x2_t){acc[ai][1][m][1][2 * h], acc[ai][1][m][1][2 * h + 1]});
                    const f32x2_t a0 = {acc[ai][0][m][0][2 * h], acc[ai][0][m][0][2 * h + 1]}, a1 = {acc[ai][0][m][1][2 * h], acc[ai][0][m][1][2 * h + 1]};
                    const f32x2_t q0 = (f32x2_t){v0[2 * h], v0[2 * h + 1]} + ((f32x2_t){g0[2 * h], g0[2 * h + 1]} * a0) * s0, q1 = (f32x2_t){v1[2 * h], v1[2 * h + 1]} + ((f32x2_t){g1[2 * h], g1[2 * h + 1]} * a1) * s1;
                    v0[2 * h] = q0.x; v0[2 * h + 1] = q0.y; v1[2 * h] = q1.x; v1[2 * h + 1] = q1.y; }
                *(u32x4*)(xb + (ai * 4 + m) * 512) = f32_to_h8(v0, v1);
                float ss = (v0[0] * v0[0] + v0[1] * v0[1]) + (v0[2] * v0[2] + v0[3] * v0[3]) + (v1[0] * v1[0] + v1[1] * v1[1]) + (v1[2] * v1[2] + v1[3] * v1[3]);
                *(u32x4*)(HA + row * XD + col0) = f32_to_bf8(v0 * m0, v1 * m1);
                ss += bperm_f(ln ^ 16, ss); ss += bperm_f(ln ^ 32, ss);
                if (fq == 0) atomicAdd(rss + row, rss_fix(ss)); }
    }
};
struct EpiU {
    static constexpr bool PERM = true, AFTER_DRAIN = false, PREFETCH = false;
    bf16_t* A2; const rss_t* rss; const float* bias;
    __device__ __forceinline__ void operator()(const f32x4 (&acc)[2][2][4][2], const Unit& u, int wr, int wc, int fr, int fq) const {
        const int b = batch_of_tile(u.pm); const float* bp = bias + (size_t)b * XD + u.pn * BM + wc * 32 + 8 * fq;
        f32x4 bv[2][2];
#pragma unroll
        for (int bj = 0; bj < 2; ++bj) { bv[bj][0] = *(const f32x4*)(bp + bj * HALF); bv[bj][1] = *(const f32x4*)(bp + bj * HALF + 4); }
        float rsv[2][4];
#pragma unroll
        for (int ai = 0; ai < 2; ++ai)
#pragma unroll
            for (int m = 0; m < 4; ++m) rsv[ai][m] = rstd_of(rss, (size_t)(u.pm * BM + ai * HALF + wr * 64 + m * 16 + fr));
#pragma unroll
        for (int ai = 0; ai < 2; ++ai)
#pragma unroll
            for (int m = 0; m < 4; ++m) { const size_t row = (size_t)(u.pm * BM + ai * HALF + wr * 64 + m * 16 + fr); const float rs = rsv[ai][m];
#pragma unroll
                for (int bj = 0; bj < 2; ++bj) { const int col0 = u.pn * BM + bj * HALF + wc * 32 + 8 * fq;
                    const f32x4 v0 = acc[ai][bj][m][0] * rs + bv[bj][0], v1 = acc[ai][bj][m][1] * rs + bv[bj][1];
                    u32x4 w; w.x = cvt_pk_bf16(v0[0], v0[1]); w.y = cvt_pk_bf16(v0[2], v0[3]); w.z = cvt_pk_bf16(v1[0], v1[1]); w.w = cvt_pk_bf16(v1[2], v1[3]);
                    *(u32x4*)(A2 + ((size_t)(col0 >> 4) * XNCH + (row >> 5)) * 768 + (row & 31) * 16 + (col0 & 15)) = w; } }
    }
};
struct EpiE {
    static constexpr bool PERM = true, AFTER_DRAIN = false, PREFETCH = false;
    float* E;
    __device__ __forceinline__ void operator()(const f32x4 (&acc)[2][2][4][2], const Unit& u, int wr, int wc, int fr, int fq) const {
        const int cb = wc * 32 + 8 * fq;
#pragma unroll
        for (int ai = 0; ai < 2; ++ai)
#pragma unroll
            for (int m = 0; m < 4; ++m) { float* rowp = E + ((size_t)u.gb * XNCH + (size_t)(u.pm * BM + ai * HALF + wr * 64 + m * 16 + fr)) * 256 + cb;
#pragma unroll
                for (int bj = 0; bj < 2; ++bj)
#pragma unroll
                    for (int n = 0; n < 2; ++n) *(f32x4*)(rowp + bj * HALF + 4 * n) = acc[ai][bj][m][n]; }
    }
};
struct EpiS2 {
    static constexpr bool PERM = true, AFTER_DRAIN = false, PREFETCH = false;
    bf16_t* Z;
    __device__ __forceinline__ void operator()(const f32x4 (&acc)[2][2][4][2], const Unit& u, int wr, int wc, int fr, int fq) const {
#pragma unroll
        for (int ai = 0; ai < 2; ++ai)
#pragma unroll
            for (int m = 0; m < 4; ++m) { const size_t row = (size_t)(u.pm * BM + ai * HALF + wr * 64 + m * 16 + fr);
#pragma unroll
                for (int bj = 0; bj < 2; ++bj) { const int col0 = u.pn * BM + bj * HALF + wc * 32 + 8 * fq; u32x4 w;
#pragma unroll
                    for (int n = 0; n < 2; ++n)
#pragma unroll
                        for (int h = 0; h < 2; ++h) { const f32x2_t o = gelu_tanh_pk((f32x2_t){acc[ai][bj][m][n][2 * h], acc[ai][bj][m][n][2 * h + 1]}); w[n * 2 + h] = cvt_pk_bf16(o.x, o.y); }
                    *(u32x4*)(Z + (row * 32 + (size_t)(col0 >> 4)) * XD + u.gb * 16 + (col0 & 15)) = w; } }
    }
};
struct EpiQKV {
    static constexpr bool PERM = true, AFTER_DRAIN = false, PREFETCH = false;
    bf16_t* QKV; const float* qg; const float* kg; PG8_LAS float* P; const rss_t* rss; const float* bias;
    __device__ __forceinline__ void operator()(f32x4 (&acc)[2][2][4][2], const Unit& u, int wr, int wc, int fr, int fq) const {
        const bool nrm = u.pn < 5;
        {
            const int b = batch_of_tile(u.pm); const float* bp = bias + (size_t)b * 1536 + u.pn * BM + wc * 32 + 8 * fq;
            rss_t rv[2][4]; float rsv[2][4];
#pragma unroll
            for (int ai = 0; ai < 2; ++ai)
#pragma unroll
                for (int m = 0; m < 4; ++m) rv[ai][m] = rss[(size_t)(u.pm * BM + ai * HALF + wr * 64 + m * 16 + fr)];
            f32x4 bv[2][2];
#pragma unroll
            for (int bj = 0; bj < 2; ++bj) { bv[bj][0] = *(const f32x4*)(bp + bj * HALF); bv[bj][1] = *(const f32x4*)(bp + bj * HALF + 4); }
            asm volatile("" ::: "memory");
#pragma unroll
            for (int ai = 0; ai < 2; ++ai)
#pragma unroll
                for (int m = 0; m < 4; ++m) rsv[ai][m] = __builtin_amdgcn_rsqf((float)rv[ai][m] * (1.0f / (1048576.0f * 1024.0f)) + 1e-6f);
#pragma unroll
            for (int ai = 0; ai < 2; ++ai)
#pragma unroll
                for (int m = 0; m < 4; ++m) { const float rs = rsv[ai][m];
#pragma unroll
                    for (int bj = 0; bj < 2; ++bj)
#pragma unroll
                        for (int n = 0; n < 2; ++n) acc[ai][bj][m][n] = acc[ai][bj][m][n] * rs + bv[bj][n]; }
        }
        if (nrm) {
#pragma unroll
            for (int ai = 0; ai < 2; ++ai)
#pragma unroll
                for (int m = 0; m < 4; ++m)
#pragma unroll
                    for (int bj = 0; bj < 2; ++bj) { const f32x4 a0 = acc[ai][bj][m][0], a1 = acc[ai][bj][m][1];
                        float s = (a0[0] * a0[0] + a0[1] * a0[1]) + (a0[2] * a0[2] + a0[3] * a0[3]) + (a1[0] * a1[0] + a1[1] * a1[1]) + (a1[2] * a1[2] + a1[3] * a1[3]);
                        { const int ln = fq * 16 + fr; s += __builtin_bit_cast(float, __builtin_amdgcn_ds_bpermute((ln ^ 16) << 2, __builtin_bit_cast(int, s))); s += __builtin_bit_cast(float, __builtin_amdgcn_ds_bpermute((ln ^ 32) << 2, __builtin_bit_cast(int, s))); }
                        if (fq == 0) P[(bj * 256 + ai * HALF + wr * 64 + m * 16 + fr) * 4 + wc] = s; }
        }
        asm volatile("s_waitcnt lgkmcnt(0)" ::: "memory"); __builtin_amdgcn_s_barrier(); asm volatile("" ::: "memory");
        const int col0 = u.pn * BM + wc * 32 + 8 * fq;
        if (nrm) {
            const float* gsrc = (u.pn < 4) ? qg : kg;
            const int dbase = (wc >> 1) * 64 + (wc & 1) * 16 + 4 * fq;
            const f32x4 g1 = *(const f32x4*)(gsrc + dbase), g2 = *(const f32x4*)(gsrc + dbase + 32);
            float inv[4];
#pragma unroll
            for (int e = 0; e < 4; ++e) inv[e] = __builtin_amdgcn_exp2f(-(float)((wc & 1) * 16 + 4 * fq + e) * (13.287712379549449f / 32.0f)) * 0.15915494309189535f;
            const int seq0 = u.pm < 64 ? 0 : 16384 + ((u.pm - 64) >> 5) * 8192;
#pragma unroll
            for (int ai = 0; ai < 2; ++ai)
#pragma unroll
                for (int m = 0; m < 4; ++m) { const int rl = ai * HALF + wr * 64 + m * 16 + fr, row = u.pm * BM + rl, l = row - seq0;
                    const float pos = (float)((wc >> 1) ? (l & 63) : (l >> 6));
                    float cs[4], sn[4];
#pragma unroll
                    for (int e = 0; e < 4; ++e) { float rev = pos * inv[e]; rev = rev - floorf(rev); cs[e] = __builtin_amdgcn_cosf(rev); sn[e] = __builtin_amdgcn_sinf(rev); }
#pragma unroll
                    for (int bj = 0; bj < 2; ++bj) { const f32x4 pp = *(const PG8_LAS f32x4*)(P + (bj * 256 + rl) * 4);
                        const float rstd = __builtin_amdgcn_rsqf(((pp[0] + pp[1]) + (pp[2] + pp[3])) * (1.0f / 128.0f) + 1e-6f);
                        float o1[4], o2[4];
#pragma unroll
                        for (int e = 0; e < 4; ++e) { const float y1 = acc[ai][bj][m][0][e] * rstd * g1[e], y2 = acc[ai][bj][m][1][e] * rstd * g2[e];
                            o1[e] = y1 * cs[e] - y2 * sn[e]; o2[e] = y2 * cs[e] + y1 * sn[e]; }
                        u32x4 w; w.x = cvt_pk_bf16(o1[0], o1[1]); w.y = cvt_pk_bf16(o1[2], o1[3]); w.z = cvt_pk_bf16(o2[0], o2[1]); w.w = cvt_pk_bf16(o2[2], o2[3]);
                        *(u32x4*)(QKV + (size_t)row * 1536 + col0 + bj * HALF) = w; }
                    if ((m & 3) == 3) asm volatile("" ::: "memory"); }
        } else {
#pragma unroll
            for (int ai = 0; ai < 2; ++ai)
#pragma unroll
                for (int m = 0; m < 4; ++m) { const size_t row = (size_t)(u.pm * BM + ai * HALF + wr * 64 + m * 16 + fr);
#pragma unroll
                    for (int bj = 0; bj < 2; ++bj) { const f32x4 v0 = acc[ai][bj][m][0], v1 = acc[ai][bj][m][1];
                        u32x4 w; w.x = cvt_pk_bf16(v0[0], v0[1]); w.y = cvt_pk_bf16(v0[2], v0[3]); w.z = cvt_pk_bf16(v1[0], v1[1]); w.w = cvt_pk_bf16(v1[2], v1[3]);
                        *(u32x4*)(QKV + row * 1536 + col0 + bj * HALF) = w; } }
        }
    }
};

template <class Epi, class Sched, bool ALIGN_EPI = false, bool SP2 = false>
__device__ __forceinline__ void gemm_phase(PG8_LAS unsigned char* lds, const Gemm g, const Sched& S, const Epi& E, const int wave_s) {
    const int lane = lane_id_asm();
    int wid_l = wave_s; asm volatile("" : "+s"(wid_l));
    const int wid = wid_l, tid = wid_l * 64 + lane, wr = wid >> 2, wc = wid & 3, fr = lane & 15, fq = lane >> 4;
    const int K = g.K, nt = K / BK, lda = g.lda ? g.lda : g.K;
    unsigned voffA[2], voffB[2];
#pragma unroll
    for (int i = 0; i < 2; ++i) { int R, C; stage_rc(tid * 16 + i * 8192, R, C); const int Rb = Epi::PERM ? ((R & ~31) + perm32(R & 31)) : R;
        voffA[i] = (unsigned)(R * lda + C) * 2u; voffB[i] = (unsigned)(Rb * K + C) * 2u; }
    const size_t kstep = (size_t)(BK * 2);
    const size_t hstep = (size_t)HALF * K * 2, hstepA = (size_t)HALF * lda * 2, tstepA = 2 * hstepA;
    const size_t tstep = 2 * hstep;
    const unsigned ldsw = (unsigned)wid * 1024u;
    const int aoff = lds_byte(wr * 64 + fr, fq * 8), boff = lds_byte(wc * 32 + fr, fq * 8);
#define PG8_SA(b, h) (((b) * 2 + (h)) * HTB)
#define PG8_SB(b, h) ((4 + (b) * 2 + (h)) * HTB)
#define PG8_STAGE(bufoff, gbase, voff) do { _Pragma("unroll") for (int _i = 0; _i < 2; ++_i) \
        __builtin_amdgcn_global_load_lds((const unsigned*)((const char*)(gbase) + (voff)[_i]), (PG8_LAS unsigned*)(lds + (bufoff) + ldsw + _i * 8192), 16, 0, 0); } while (0)
#define PG8_LDA(dst, b, h) do { _Pragma("unroll") for (int m = 0; m < 4; ++m) _Pragma("unroll") for (int k = 0; k < 2; ++k) dst[m][k] = *(const PG8_LAS bf16x8*)(lds + PG8_SA(b, h) + aoff + m * 2048 + k * 1024); } while (0)
#define PG8_LDB(dst, b, h) do { _Pragma("unroll") for (int n = 0; n < 2; ++n) _Pragma("unroll") for (int k = 0; k < 2; ++k) dst[n][k] = *(const PG8_LAS bf16x8*)(lds + PG8_SB(b, h) + boff + n * 2048 + k * 1024); } while (0)
#define PG8_MMA(ai, bj, At, Bt) do { __builtin_amdgcn_s_setprio(1); _Pragma("unroll") for (int m = 0; m < 4; ++m) _Pragma("unroll") for (int n = 0; n < 2; ++n) _Pragma("unroll") for (int k = 0; k < 2; ++k) \
        acc[ai][bj][m][n] = __builtin_amdgcn_mfma_f32_16x16x32_bf16(Bt[n][k], At[m][k], acc[ai][bj][m][n], 0, 0, 0); __builtin_amdgcn_s_setprio(0); } while (0)
#define PG8_WAIT_V(n) asm volatile("s_waitcnt vmcnt(" #n ")" ::: "memory")
#define PG8_WAIT_L(n) asm volatile("s_waitcnt lgkmcnt(" #n ")" ::: "memory")
#define PG8_BAR __builtin_amdgcn_s_barrier()
#define PG8_SCHED __builtin_amdgcn_sched_barrier(0)
    Unit cur, nxt; int ui = 0;
    if (!S.next(0, cur)) return;
    f32x4 acc[2][2][4][2];
#pragma unroll
    for (int a = 0; a < 2; ++a)
#pragma unroll
        for (int b = 0; b < 2; ++b)
#pragma unroll
            for (int m = 0; m < 4; ++m)
#pragma unroll
                for (int n = 0; n < 2; ++n) acc[a][b][m][n] = (f32x4){0.f, 0.f, 0.f, 0.f};
    bf16x8 At[4][2], B0[2][2], B1[2][2];
    const char* cA = (const char*)g.A + (size_t)cur.gb * g.strideA + (size_t)cur.pm * tstepA; const char* cB = (const char*)g.Bt + (size_t)cur.gb * g.strideB + (size_t)cur.pn * tstep;
    S.a_ready(cur);
    if constexpr (SP2) {
        PG8_STAGE(PG8_SB(0, 0), cB, voffB); PG8_STAGE(PG8_SB(0, 1), cB + hstep, voffB); PG8_STAGE(PG8_SA(0, 0), cA, voffA); PG8_STAGE(PG8_SA(0, 1), cA + hstepA, voffA);
        if (wr == 1) PG8_BAR;
        PG8_WAIT_V(2); PG8_BAR;
        PG8_STAGE(PG8_SB(1, 0), cB + kstep, voffB); PG8_STAGE(PG8_SA(1, 0), cA + kstep, voffA); PG8_STAGE(PG8_SB(1, 1), cB + hstep + kstep, voffB);
        PG8_WAIT_V(6); PG8_BAR;
    } else {
        PG8_STAGE(PG8_SB(0, 0), cB, voffB); PG8_STAGE(PG8_SA(0, 0), cA, voffA); PG8_STAGE(PG8_SB(0, 1), cB + hstep, voffB); PG8_STAGE(PG8_SA(0, 1), cA + hstepA, voffA);
        if (wr == 1) PG8_BAR;
        PG8_WAIT_V(4); PG8_BAR;
        PG8_STAGE(PG8_SB(1, 0), cB + kstep, voffB); PG8_STAGE(PG8_SA(1, 0), cA + kstep, voffA); PG8_STAGE(PG8_SB(1, 1), cB + hstep + kstep, voffB);
        PG8_WAIT_V(6); PG8_BAR;
    }
    for (;;) {
        const bool has_next = S.next(ui + 1, nxt);
        const char* nA = has_next ? (const char*)g.A + (size_t)nxt.gb * g.strideA + (size_t)nxt.pm * tstepA : cA; const char* nB = has_next ? (const char*)g.Bt + (size_t)nxt.gb * g.strideB + (size_t)nxt.pn * tstep : cB;
        for (int t = 0; t < nt; t += 2) {
            const bool last = (t == nt - 2);
            const char* a1 = cA + (size_t)(t + 1) * kstep;
            const char* a2 = last ? nA : cA + (size_t)(t + 2) * kstep; const char* b2 = last ? nB : cB + (size_t)(t + 2) * kstep;
            const char* a3 = a2 + kstep; const char* b3 = b2 + kstep;
            if (last && has_next) S.a_ready(nxt);
            if constexpr (SP2) {
            PG8_LDB(B0, 0, 0); PG8_LDB(B1, 0, 1); PG8_SCHED; PG8_LDA(At, 0, 0); PG8_STAGE(PG8_SA(1, 1), a1 + hstepA, voffA);
            PG8_WAIT_V(8); PG8_WAIT_L(0); PG8_BAR; PG8_MMA(0, 0, At, B0); PG8_MMA(0, 1, At, B1); PG8_BAR; PG8_SCHED;
            PG8_LDA(At, 0, 1); PG8_STAGE(PG8_SB(0, 0), b2, voffB); PG8_STAGE(PG8_SB(0, 1), b2 + hstep, voffB); PG8_STAGE(PG8_SA(0, 0), a2, voffA);
            PG8_WAIT_V(8); PG8_WAIT_L(0); PG8_BAR; PG8_MMA(1, 0, At, B0); PG8_MMA(1, 1, At, B1); PG8_BAR; PG8_SCHED;
            PG8_LDB(B0, 1, 0); PG8_LDB(B1, 1, 1); PG8_SCHED; PG8_LDA(At, 1, 0); PG8_STAGE(PG8_SA(0, 1), a2 + hstepA, voffA);
            PG8_WAIT_V(8); PG8_WAIT_L(0); PG8_BAR; PG8_MMA(0, 0, At, B0); PG8_MMA(0, 1, At, B1); PG8_BAR; PG8_SCHED;
            PG8_LDA(At, 1, 1); PG8_STAGE(PG8_SB(1, 0), b3, voffB); PG8_STAGE(PG8_SB(1, 1), b3 + hstep, voffB); PG8_STAGE(PG8_SA(1, 0), a3, voffA);
            PG8_WAIT_V(8); PG8_WAIT_L(0); PG8_BAR; PG8_MMA(1, 0, At, B0); PG8_MMA(1, 1, At, B1); PG8_BAR; PG8_SCHED;
            } else {
            PG8_LDB(B0, 0, 0); PG8_SCHED; PG8_LDA(At, 0, 0); PG8_STAGE(PG8_SA(1, 1), a1 + hstepA, voffA);
            PG8_WAIT_L(8); PG8_BAR; PG8_WAIT_L(0); PG8_MMA(0, 0, At, B0); PG8_BAR; PG8_SCHED;
            PG8_LDB(B1, 0, 1); PG8_STAGE(PG8_SB(0, 0), b2, voffB);
            PG8_BAR; PG8_WAIT_L(0); PG8_MMA(0, 1, At, B1); PG8_BAR;
            PG8_LDA(At, 0, 1); PG8_STAGE(PG8_SA(0, 0), a2, voffA);
            PG8_BAR; PG8_WAIT_L(0); PG8_MMA(1, 0, At, B0); PG8_BAR; PG8_SCHED;
            PG8_STAGE(PG8_SB(0, 1), b2 + hstep, voffB);
            PG8_WAIT_V(6); PG8_BAR; PG8_MMA(1, 1, At, B1); PG8_BAR;
            PG8_LDB(B0, 1, 0); PG8_SCHED; PG8_LDA(At, 1, 0); PG8_STAGE(PG8_SA(0, 1), a2 + hstepA, voffA);
            PG8_WAIT_L(8); PG8_BAR; PG8_WAIT_L(0); PG8_MMA(0, 0, At, B0); PG8_BAR; PG8_SCHED;
            PG8_LDB(B1, 1, 1); PG8_STAGE(PG8_SB(1, 0), b3, voffB);
            PG8_BAR; PG8_WAIT_L(0); PG8_MMA(0, 1, At, B1); PG8_BAR;
            PG8_LDA(At, 1, 1); PG8_STAGE(PG8_SA(1, 0), a3, voffA);
            PG8_BAR; PG8_WAIT_L(0); PG8_MMA(1, 0, At, B0); PG8_BAR; PG8_SCHED;
            PG8_STAGE(PG8_SB(1, 1), b3 + hstep, voffB);
            PG8_WAIT_V(6); PG8_BAR; PG8_MMA(1, 1, At, B1); PG8_BAR;
            }
        }
        if constexpr (ALIGN_EPI) { if (wr == 0) PG8_BAR; }
        if constexpr (!Epi::AFTER_DRAIN) { E(acc, cur, wr, wc, fr, fq); S.done(cur); }
        if (!has_next) break;
#pragma unroll
        for (int a = 0; a < 2; ++a)
#pragma unroll
            for (int b = 0; b < 2; ++b)
#pragma unroll
                for (int m = 0; m < 4; ++m)
#pragma unroll
                    for (int n = 0; n < 2; ++n) acc[a][b][m][n] = (f32x4){0.f, 0.f, 0.f, 0.f};
        cur = nxt; cA = nA; cB = nB; ++ui;
        if constexpr (ALIGN_EPI) { if (wr == 1) PG8_BAR; }
    }
    PG8_WAIT_V(0);
    if constexpr (!ALIGN_EPI) { if (wr == 0) PG8_BAR; }
    PG8_BAR;
    if constexpr (Epi::AFTER_DRAIN) { E.fused(acc, cur, wr, wc, fr, fq, lds, wid, lane); S.done(cur); }
#undef PG8_SA
#undef PG8_SB
#undef PG8_STAGE
#undef PG8_LDA
#undef PG8_LDB
#undef PG8_MMA
#undef PG8_WAIT_V
#undef PG8_WAIT_L
#undef PG8_BAR
#undef PG8_SCHED
}
}

namespace attn {
using bf16 = __hip_bfloat16;
constexpr int   D = 128, NW = 8, QBLK = 32, KVBLK = 64;
constexpr float SCALE = 0.088388347648318440f;
constexpr float THR = 8.f;
constexpr int SDEPTH = 2;
constexpr int LDQ = 1536, LDK = 1536, LDO = 1024;
constexpr size_t SHM_V = KVBLK * D * 2, SHM_K = KVBLK * D * 2, SHM_ATTN = 2 * SHM_V + 2 * SHM_K + NW * 64 * 4;
__device__ __forceinline__ unsigned short f2bf_rne(float f) { unsigned u = __builtin_bit_cast(unsigned, f); return (unsigned short)((u + 0x7fffu + ((u >> 16) & 1u)) >> 16); }
using bf16x8 = __attribute__((ext_vector_type(8))) short;
using s16x4  = __attribute__((ext_vector_type(4))) short;
using f32x16 = __attribute__((ext_vector_type(16))) float;
using f32x8  = __attribute__((ext_vector_type(8))) float;
using u32x4  = __attribute__((ext_vector_type(4))) unsigned;
#define KSWZ(row, colB) ((row) * 256 + ((colB) ^ (((row) & 7) << 4)))
#define SBAR() __builtin_amdgcn_sched_barrier(0)
__device__ __forceinline__ int crow(int r, int hi) { return (r & 3) + 8 * (r >> 2) + 4 * hi; }
__device__ __forceinline__ unsigned cvtpk(float lo, float hi) {
  unsigned r; asm volatile("v_cvt_pk_bf16_f32 %0, %1, %2" : "=v"(r) : "v"(lo), "v"(hi)); return r;
}
template <typename TIn> struct Stage;
template <> struct Stage<bf16>  { using T = bf16x8;
  __device__ static __forceinline__ T ld8(const bf16* p) { return *reinterpret_cast<const bf16x8*>(p); }
  __device__ static __forceinline__ bf16x8 tobf(T x) { return x; } };
template <> struct Stage<float> { using T = f32x8;
  __device__ static __forceinline__ T ld8(const float* p) { return *reinterpret_cast<const f32x8*>(p); }
  __device__ static __forceinline__ bf16x8 tobf(T x) {
    u32x4 w = {cvtpk(x[0], x[1]), cvtpk(x[2], x[3]), cvtpk(x[4], x[5]), cvtpk(x[6], x[7])}; return *reinterpret_cast<bf16x8*>(&w); } };

__device__ __forceinline__ void partialSM(f32x16& p0, f32x16& p1, float& m_reg, float& mn, float& alpha) {
  constexpr float C = SCALE * 1.4426950408889634f;
  float pmax = p0[0]; for (int r = 1; r < 16; ++r) pmax = fmaxf(pmax, p0[r]); for (int r = 0; r < 16; ++r) pmax = fmaxf(pmax, p1[r]);
  { auto rr = __builtin_amdgcn_permlane32_swap(__float_as_uint(pmax), __float_as_uint(pmax), false, false);
    pmax = fmaxf(__uint_as_float(rr[0]), __uint_as_float(rr[1])); }
  if (__builtin_expect(__all(pmax - m_reg <= THR / SCALE), 1)) { mn = m_reg; alpha = 1.f; }
  else { mn = fmaxf(m_reg, pmax); alpha = __builtin_amdgcn_exp2f((m_reg - mn) * C); m_reg = mn; }
  float mnC = -mn * C;
  for (int r = 0; r < 16; ++r) p0[r] = fmaf(p0[r], C, mnC); for (int r = 0; r < 16; ++r) p1[r] = fmaf(p1[r], C, mnC);
  for (int r = 0; r < 16; ++r) p0[r] = __builtin_amdgcn_exp2f(p0[r]);
}
__device__ __forceinline__ void finishSM(f32x16& p0, f32x16& p1, float alpha, float& l_reg, bf16x8& pa0, bf16x8& pa1, bf16x8& pa2, bf16x8& pa3) {
  for (int r = 0; r < 16; ++r) p1[r] = __builtin_amdgcn_exp2f(p1[r]);
  float ps = 0; for (int r = 0; r < 16; ++r) ps += p0[r]; for (int r = 0; r < 16; ++r) ps += p1[r];
  { auto rr = __builtin_amdgcn_permlane32_swap(__float_as_uint(ps), __float_as_uint(ps), false, false);
    ps = __uint_as_float(rr[0]) + __uint_as_float(rr[1]); }
  l_reg = l_reg * alpha + ps;
#define PK4(P, BASE, OUT) do { unsigned a0 = cvtpk(P[BASE + 0], P[BASE + 1]), a1 = cvtpk(P[BASE + 2], P[BASE + 3]);   \
    unsigned b0 = cvtpk(P[BASE + 4], P[BASE + 5]), b1 = cvtpk(P[BASE + 6], P[BASE + 7]);                              \
    auto r0 = __builtin_amdgcn_permlane32_swap(a0, b0, false, false); auto r1 = __builtin_amdgcn_permlane32_swap(a1, b1, false, false); \
    u32x4 w = {r0[0], r1[0], r0[1], r1[1]}; OUT = *reinterpret_cast<bf16x8*>(&w); } while (0)
  PK4(p0, 0, pa0); PK4(p0, 8, pa1); PK4(p1, 0, pa2); PK4(p1, 8, pa3);
#undef PK4
}
__device__ __forceinline__ void qkt(f32x16& p0, f32x16& p1, const bf16* Ks, const bf16x8* qr, int r32, int hi) {
  p0 = f32x16{}; p1 = f32x16{};
  for (int d0 = 0; d0 < 8; ++d0) { int cb = (d0 * 16 + hi * 8) * 2;
    bf16x8 b0 = *reinterpret_cast<const bf16x8*>((const char*)Ks + KSWZ(r32, cb));
    bf16x8 b1 = *reinterpret_cast<const bf16x8*>((const char*)Ks + KSWZ(32 + r32, cb));
    p0 = __builtin_amdgcn_mfma_f32_32x32x16_bf16(b0, qr[d0], p0, 0, 0, 0);
    p1 = __builtin_amdgcn_mfma_f32_32x32x16_bf16(b1, qr[d0], p1, 0, 0, 0); }
}
__device__ __forceinline__ int v_st(int k, int c) { const int kk = (k & ~0xC) | ((k & 4) << 1) | ((k & 8) >> 1); return ((kk >> 3) * 4 + (c >> 5)) * 512 + ((kk & 7) * 32 + (c & 31)) * 2; }
__device__ __forceinline__ int v_rd_base(int lane) { return ((lane & 3) << 3) | (((lane >> 2) & 3) << 6) | (((lane >> 4) & 1) << 5) | (((lane >> 5) & 1) << 8); }
constexpr int v_rd_off(int d0, int ks, int half) { return d0 * 512 + ks * 4096 + half * 2048; }
template <int OFF> __device__ __forceinline__ s16x4 tr_read(int vb) {
  s16x4 r; asm volatile("ds_read_b64_tr_b16 %0, %1 offset:%2" : "=&v"(r) : "v"(vb), "i"(OFF) : "memory"); return r;
}
template <int D0> __device__ __forceinline__ void pv_one(f32x16& od, int vb, bf16x8 pa0, bf16x8 pa1, bf16x8 pa2, bf16x8 pa3) {
  const s16x4 l0 = tr_read<v_rd_off(D0, 0, 0)>(vb), h0 = tr_read<v_rd_off(D0, 0, 1)>(vb), l1 = tr_read<v_rd_off(D0, 1, 0)>(vb), h1 = tr_read<v_rd_off(D0, 1, 1)>(vb);
  const s16x4 l2 = tr_read<v_rd_off(D0, 2, 0)>(vb), h2 = tr_read<v_rd_off(D0, 2, 1)>(vb), l3 = tr_read<v_rd_off(D0, 3, 0)>(vb), h3 = tr_read<v_rd_off(D0, 3, 1)>(vb);
  asm volatile("s_waitcnt lgkmcnt(0)" ::: "memory"); SBAR();
#define PK(L, H) (bf16x8){L[0], L[1], L[2], L[3], H[0], H[1], H[2], H[3]}
  od = __builtin_amdgcn_mfma_f32_32x32x16_bf16(pa0, PK(l0, h0), od, 0, 0, 0);
  od = __builtin_amdgcn_mfma_f32_32x32x16_bf16(pa1, PK(l1, h1), od, 0, 0, 0);
  od = __builtin_amdgcn_mfma_f32_32x32x16_bf16(pa2, PK(l2, h2), od, 0, 0, 0);
  od = __builtin_amdgcn_mfma_f32_32x32x16_bf16(pa3, PK(l3, h3), od, 0, 0, 0);
#undef PK
}
__device__ __forceinline__ void pv_d0(f32x16* o, int vb, bf16x8 pa0, bf16x8 pa1, bf16x8 pa2, bf16x8 pa3) {
  pv_one<0>(o[0], vb, pa0, pa1, pa2, pa3); pv_one<1>(o[1], vb, pa0, pa1, pa2, pa3); pv_one<2>(o[2], vb, pa0, pa1, pa2, pa3); pv_one<3>(o[3], vb, pa0, pa1, pa2, pa3);
}

template <typename TQ>
__device__ __forceinline__ void attn_dense_body(const TQ* __restrict__ Qb, const bf16* __restrict__ Kh, const bf16* __restrict__ Vh,
                                                unsigned short* __restrict__ Ob, int seq, char* lds, const int wave_s) {
  using St = Stage<bf16>; using SQ = Stage<TQ>;
  const int lane = lane_id_asm(), wid = wave_s, tid = wave_s * 64 + lane, r32 = lane & 31, hi = lane >> 5;
  bf16* V_lds = (bf16*)lds; bf16* K_lds = (bf16*)(lds + 2 * SHM_V);
  float* ws = (float*)(lds + 2 * SHM_V + 2 * SHM_K) + wid * 64; float* li_l = ws; float* al_l = ws + 32;
  float m_reg = -1e30f, l_reg = 0; f32x16 o[4] = {}; bf16x8 qr[8];
  const TQ* Qw = Qb + (long)(wid * QBLK + r32) * LDQ + hi * 8;
#pragma unroll
  for (int d0 = 0; d0 < 8; ++d0) qr[d0] = SQ::tobf(SQ::ld8(Qw + d0 * 16));
  const int sr = tid >> 4, sc = (tid & 15) * 8, vst0 = v_st(sr, sc), vst1 = v_st(32 + sr, sc);
  const int vb0 = (int)(uintptr_t)V_lds + v_rd_base(lane);
  struct { typename St::T vs0, vs1, ks0, ks1; } sr_[SDEPTH];
#define SLOAD(i, k0) do { sr_[i].vs0 = St::ld8(&Vh[(long)((k0) + sr) * LDK + sc]); sr_[i].vs1 = St::ld8(&Vh[(long)((k0) + 32 + sr) * LDK + sc]); \
    sr_[i].ks0 = St::ld8(&Kh[(long)((k0) + sr) * LDK + sc]); sr_[i].ks1 = St::ld8(&Kh[(long)((k0) + 32 + sr) * LDK + sc]); } while (0)
#define SWRITE(b, i) do { *(bf16x8*)((char*)V_lds + (b) * SHM_V + vst0) = St::tobf(sr_[i].vs0);          \
    *(bf16x8*)((char*)V_lds + (b) * SHM_V + vst1) = St::tobf(sr_[i].vs1); int kc = sc * 2;               \
    *(bf16x8*)((char*)K_lds + (b) * SHM_K + KSWZ(sr, kc)) = St::tobf(sr_[i].ks0);                       \
    *(bf16x8*)((char*)K_lds + (b) * SHM_K + KSWZ(32 + sr, kc)) = St::tobf(sr_[i].ks1); } while (0)
#define SWAIT() do { if constexpr (SDEPTH == 2) asm volatile("s_waitcnt vmcnt(4)" ::: "memory"); else asm volatile("s_waitcnt vmcnt(0)" ::: "memory"); } while (0)
#define RESC(a) do { if (__any((a) < 1.f)) { if (hi == 0) al_l[r32] = (a); asm volatile("s_waitcnt lgkmcnt(0)" ::: "memory"); \
    for (int d = 0; d < 4; ++d) for (int r = 0; r < 16; ++r) o[d][r] *= al_l[crow(r, hi)]; } } while (0)
  f32x16 pA0, pA1, pB0, pB1; float mnA, mnB, alA, alB; bf16x8 pa0, pa1, pa2, pa3; const int NT = seq / KVBLK;
  constexpr int SE = 0, SO = SDEPTH - 1;
  SLOAD(SE, 0); asm volatile("s_waitcnt vmcnt(0)" ::: "memory"); SWRITE(0, SE); __syncthreads();
  qkt(pA0, pA1, K_lds, qr, r32, hi); partialSM(pA0, pA1, m_reg, mnA, alA);
  SLOAD(SO, KVBLK); if constexpr (SDEPTH == 2) { if (2 < NT) SLOAD(SE, 2 * KVBLK); }
  SWAIT(); SWRITE(1, SO); __syncthreads();
  for (int j = 1; j + 1 < NT; j += 2) {
    SBAR(); qkt(pB0, pB1, (bf16*)((char*)K_lds + SHM_K), qr, r32, hi);
    finishSM(pA0, pA1, alA, l_reg, pa0, pa1, pa2, pa3); SBAR();
    SLOAD(SO, (j + SDEPTH) * KVBLK); SBAR();
    pv_d0(o, vb0, pa0, pa1, pa2, pa3); partialSM(pB0, pB1, m_reg, mnB, alB);
    __syncthreads(); SWAIT(); SWRITE(0, SE);
    RESC(alB); __syncthreads();
    SBAR(); qkt(pA0, pA1, K_lds, qr, r32, hi);
    finishSM(pB0, pB1, alB, l_reg, pa0, pa1, pa2, pa3); SBAR();
    if (SDEPTH == 1 || j + 3 < NT) SLOAD(SE, (j + 1 + SDEPTH) * KVBLK); SBAR();
    pv_d0(o, vb0 + (int)SHM_V, pa0, pa1, pa2, pa3); partialSM(pA0, pA1, m_reg, mnA, alA);
    __syncthreads(); SWAIT(); SWRITE(1, SO);
    RESC(alA); __syncthreads();
  }
  SBAR(); qkt(pB0, pB1, (bf16*)((char*)K_lds + SHM_K), qr, r32, hi);
  finishSM(pA0, pA1, alA, l_reg, pa0, pa1, pa2, pa3); SBAR();
  pv_d0(o, vb0, pa0, pa1, pa2, pa3); partialSM(pB0, pB1, m_reg, mnB, alB);
  __syncthreads(); RESC(alB);
  finishSM(pB0, pB1, alB, l_reg, pa0, pa1, pa2, pa3); SBAR();
  pv_d0(o, vb0 + (int)SHM_V, pa0, pa1, pa2, pa3);
  if (hi == 0) li_l[r32] = l_reg; asm volatile("s_waitcnt lgkmcnt(0)" ::: "memory");
  float rli[16];
#pragma unroll
  for (int r = 0; r < 16; ++r) rli[r] = __builtin_amdgcn_rcpf(li_l[crow(r, hi)]);
  unsigned short* Ow = Ob + (long)(wid * QBLK) * LDO;
#pragma unroll
  for (int r = 0; r < 16; ++r) { int orow = crow(r, hi);
    for (int d0 = 0; d0 < 4; ++d0) Ow[(long)orow * LDO + d0 * 32 + r32] = f2bf_rne(o[d0][r] * rli[r]); }
#undef SLOAD
#undef SWRITE
#undef SWAIT
#undef RESC
}
}

#define LAS __attribute__((address_space(3)))
typedef unsigned short bf16_t;
typedef unsigned v4u __attribute__((ext_vector_type(4)));
typedef float f32x4 __attribute__((ext_vector_type(4)));
typedef float f32x2 __attribute__((ext_vector_type(2)));
struct Args { const float* in[24]; float* out; unsigned char* ws; };
#define LDS_WAIT() asm volatile("s_waitcnt lgkmcnt(0)" ::: "memory")
__device__ __forceinline__ unsigned f2bf(float f) { unsigned u = __builtin_bit_cast(unsigned, f); return (u + 0x7fffu + ((u >> 16) & 1u)) >> 16; }
__device__ __forceinline__ unsigned pk2(float lo, float hi) { return f2bf(lo) | (f2bf(hi) << 16); }
__device__ __forceinline__ float wave_sum(float v, int lane) {
#pragma unroll
    for (int o = 1; o < 64; o <<= 1) v += __builtin_bit_cast(float, __builtin_amdgcn_ds_bpermute((lane ^ o) << 2, __builtin_bit_cast(int, v)));
    return v;
}
__device__ __forceinline__ void sincos_rev(float ang, float& s, float& c) {
    float rev = ang * 0.15915494309189535f; rev = rev - floorf(rev); s = __builtin_amdgcn_sinf(rev); c = __builtin_amdgcn_cosf(rev);
}

__device__ __forceinline__ void transpose_item(const float* __restrict__ W, int K, int N, bf16_t* __restrict__ WT, int mode, int halfw, LAS float* scr, int item, int lane) {
    const int nblk = N / 32, kb = item / nblk, nb = item % nblk, k0 = 64 * kb, n0 = 32 * nb;
    const int nn = n0 + (lane & 31);
    int sc = nn;
    if (mode == 1) { if (nn < 1280) { const int s = nn & 127; sc = (nn & ~127) + ((s >> 6) & 1) * 64 + ((s >> 5) & 1) * 16 + ((s >> 3) & 3) * 4 + (s & 3) + ((s >> 2) & 1) * 32; } }
    else if (mode == 2) sc = ((nn >> 7) & 1) * halfw + (nn >> 8) * 128 + (nn & 127);
    float tv[32];
#pragma unroll
    for (int i = 0; i < 32; ++i) tv[i] = W[(size_t)(k0 + 2 * i + (lane >> 5)) * N + sc];
#pragma unroll
    for (int i = 0; i < 32; ++i) scr[(2 * i + (lane >> 5)) * 33 + (lane & 31)] = tv[i];
    LDS_WAIT(); asm volatile("" ::: "memory");
    const int c = lane & 7;
#pragma unroll
    for (int j = 0; j < 4; ++j) { const int n = (lane >> 3) + 8 * j; const LAS float* s = scr + (8 * c) * 33 + n;
        v4u o; o.x = pk2(s[0 * 33], s[1 * 33]); o.y = pk2(s[2 * 33], s[3 * 33]); o.z = pk2(s[4 * 33], s[5 * 33]); o.w = pk2(s[6 * 33], s[7 * 33]);
        *(v4u*)(WT + (size_t)(n0 + n) * K + k0 + 8 * c) = o; }
    LDS_WAIT(); asm volatile("" ::: "memory");
}

__device__ __forceinline__ void ssm_build(const Args& a, int j, int g, LAS unsigned char* lds, unsigned char* ws) {
    const int tid = threadIdx.x;
    LAS f32x2* lam = (LAS f32x2*)lds;
    LAS f32x2* bbar = lam + 2 * 33 * 65;
    LAS f32x2* cc = bbar + 2 * 64 * 16;
    LAS float* Kt = (LAS float*)(cc + 2 * 16 * 65);
    LAS f32x2* fco = (LAS f32x2*)(Kt + 2 * 32 * 256);
    const float* a_re = a.in[12]; const float* a_im = a.in[13]; const float* log_dt = a.in[14];
    const float* b_re = a.in[15]; const float* b_im = a.in[16]; const float* c_re = a.in[17]; const float* c_im = a.in[18]; const float* dd = a.in[19];
    if (tid < 128) {
        const int dir = tid >> 6, p = tid & 63, gi = (j * 2 + dir) * 64 + g, idx = gi * 64 + p;
        const float are = a_re[idx], aim = a_im[idx], dt = expf(log_dt[gi]);
        for (int tau = 0; tau <= 32; ++tau) { const float mag = expf((float)tau * dt * are); float s, c; sincos_rev((float)tau * dt * aim, s, c); lam[(dir * 33 + tau) * 65 + p] = (f32x2){mag * c, mag * s}; }
        const float mag = expf(dt * are); float s1, c1, sh, ch; sincos_rev(dt * aim, s1, c1); sincos_rev(0.5f * dt * aim, sh, ch);
        const float nr = expm1f(dt * are) - 2.0f * mag * sh * sh, ai1 = mag * s1, den = are * are + aim * aim;
        fco[dir * 64 + p] = (f32x2){(nr * are + ai1 * aim) / den, (ai1 * are - nr * aim) / den};
    }
    __syncthreads();
    for (int e = tid; e < 2048; e += 512) {
        { const int dir = e >> 10, p = (e >> 4) & 63, h = e & 15; const size_t idx = ((size_t)((j * 2 + dir) * 64 + g) * 64 + p) * 16 + h;
          const float br = b_re[idx], bi = b_im[idx]; const f32x2 f = fco[dir * 64 + p]; bbar[e] = (f32x2){f.x * br - f.y * bi, f.x * bi + f.y * br}; }
        { const int dir = e >> 10, h = (e >> 6) & 15, p = e & 63; const size_t idx = ((size_t)((j * 2 + dir) * 64 + g) * 16 + h) * 64 + p; cc[(dir * 16 + h) * 65 + p] = (f32x2){c_re[idx], c_im[idx]}; }
    }
    __syncthreads();
    {
        const int combo = tid >> 3, dir = combo >> 5, tau = combo & 31, h0 = (tid & 7) * 2; float a0[16], a1[16];
#pragma unroll
        for (int q = 0; q < 16; ++q) { a0[q] = 0.f; a1[q] = 0.f; }
        for (int p = 0; p < 64; ++p) { const f32x2 Lv = lam[(dir * 33 + tau) * 65 + p], C0 = cc[(dir * 16 + h0) * 65 + p], C1 = cc[(dir * 16 + h0 + 1) * 65 + p];
#pragma unroll
            for (int q = 0; q < 16; ++q) { const f32x2 B = bbar[(dir * 64 + p) * 16 + q]; const float gx = Lv.x * B.x - Lv.y * B.y, gy = Lv.x * B.y + Lv.y * B.x;
                a0[q] += C0.x * gx - C0.y * gy; a1[q] += C1.x * gx - C1.y * gy; } }
#pragma unroll
        for (int q = 0; q < 16; ++q) { Kt[((dir * 32 + tau) * 16 + h0) * 16 + q] = a0[q]; Kt[((dir * 32 + tau) * 16 + h0 + 1) * 16 + q] = a1[q]; }
    }
    __syncthreads();
    bf16_t* base = (bf16_t*)(ws + WS_SSM + (size_t)(j * 64 + g) * MiB);
    for (int it = tid; it < 32768; it += 512) {
        const int n = it >> 6, kb = it & 63, t = n >> 4, h = n & 15, s = kb >> 1, hp0 = (kb & 1) * 8; float v[8];
#pragma unroll
        for (int e = 0; e < 8; ++e) { const int hp = hp0 + e; float x = 0.f;
            if (s <= t) x += Kt[((0 * 32 + (t - s)) * 16 + h) * 16 + hp];
            if (s >= t) x += Kt[((1 * 32 + (s - t)) * 16 + h) * 16 + hp];
            if (s == t && h == hp) x += dd[j * 1024 + g * 16 + h];
            v[e] = x; }
        v4u o; o.x = pk2(v[0], v[1]); o.y = pk2(v[2], v[3]); o.z = pk2(v[4], v[5]); o.w = pk2(v[6], v[7]);
        *(v4u*)(base + (size_t)n * 768 + kb * 8) = o;
    }
    for (int it = tid; it < 16384; it += 512) {
        const int n = it >> 6, kb = it & 63, dir = n >> 7, ri = (n >> 6) & 1, p = n & 63, s = kb >> 1, hp0 = (kb & 1) * 8, ex = dir ? s : 31 - s; float v[8];
        const f32x2 L = lam[(dir * 33 + ex) * 65 + p];
#pragma unroll
        for (int e = 0; e < 8; ++e) { const f32x2 B = bbar[(dir * 64 + p) * 16 + hp0 + e]; v[e] = ri ? (L.x * B.y + L.y * B.x) : (L.x * B.x - L.y * B.y); }
        v4u o; o.x = pk2(v[0], v[1]); o.y = pk2(v[2], v[3]); o.z = pk2(v[4], v[5]); o.w = pk2(v[6], v[7]);
        *(v4u*)(base + (size_t)512 * 768 + (size_t)n * 512 + kb * 8) = o;
    }
    bf16_t* wc = base + 512;
    for (int it = tid; it < 16384; it += 512) {
        const int n = it >> 5, k0 = (it & 31) * 8, dir = k0 >> 7, ri = (k0 >> 6) & 1, p0 = k0 & 63, t = n >> 4, h = n & 15, ex = dir ? 32 - t : t + 1; float v[8];
#pragma unroll
        for (int e = 0; e < 8; ++e) { const f32x2 L = lam[(dir * 33 + ex) * 65 + p0 + e], C = cc[(dir * 16 + h) * 65 + p0 + e]; v[e] = ri ? -(C.x * L.y + C.y * L.x) : (C.x * L.x - C.y * L.y); }
        v4u o; o.x = pk2(v[0], v[1]); o.y = pk2(v[2], v[3]); o.z = pk2(v[4], v[5]); o.w = pk2(v[6], v[7]);
        *(v4u*)(wc + (size_t)n * 768 + k0) = o;
    }
    if (tid < 128) { const int dir = tid >> 6, p = tid & 63; ((f32x2*)(ws + WS_LAM))[((j * 64 + g) * 2 + dir) * 64 + p] = lam[(dir * 33 + 32) * 65 + p]; }
    __syncthreads();
}

__device__ __forceinline__ void init_rows(const Args& a, const float* gain, const float* mod0, bf16_t* HA, bf16_t* XB, pg8::rss_t* rss0, int gw, int NGW) {
    const int lane = lane_id_asm(), fr = lane & 15, fq = lane >> 4;
    for (int gi = gw; gi < TT / 16; gi += NGW) {
        const int row = gi * 16 + fr, pm = gi >> 4, am = ((gi >> 3) & 1) * 4 + (gi & 3), wr = (gi >> 2) & 1;
        const float* xr = row < LP ? a.in[0] + (size_t)row * DM : a.in[1] + (size_t)(row - LP) * DM;
        const int b = row < LP ? 0 : 1 + (row - LP) / LS;
        const float* scp = mod0 + (size_t)b * 6144 + 1024;
        float ss = 0.f;
#pragma unroll 4
        for (int it = 0; it < 32; ++it) { const int pnq = it >> 2, wc = it & 3, c0 = pnq * 128 + wc * 32 + fq * 8;
            const f32x4 x0 = __builtin_nontemporal_load((const f32x4*)(xr + c0)), x1 = __builtin_nontemporal_load((const f32x4*)(xr + c0 + 4));
            const f32x4 g0 = *(const f32x4*)(gain + c0), g1 = *(const f32x4*)(gain + c0 + 4), s0 = *(const f32x4*)(scp + c0), s1 = *(const f32x4*)(scp + c0 + 4);
            ss += (x0.x * x0.x + x0.y * x0.y) + (x0.z * x0.z + x0.w * x0.w) + (x1.x * x1.x + x1.y * x1.y) + (x1.z * x1.z + x1.w * x1.w);
            *(pg8::u32x4*)(XB + ((size_t)((((pm * 8 + pnq) * 2 + wr) * 4 + wc) * 8 + am) * 64 + lane) * 8) = pg8::f32_to_h8(x0, x1);
            *(pg8::u32x4*)(HA + (size_t)row * DM + c0) = pg8::f32_to_bf8(x0 * g0 * (s0 + 1.0f), x1 * g1 * (s1 + 1.0f)); }
        ss += pg8::bperm_f(lane ^ 16, ss); ss += pg8::bperm_f(lane ^ 32, ss);
        if (fq == 0) rss0[row] = pg8::rss_fix(ss);
    }
}
__device__ __forceinline__ void bias_rows(const bf16_t* WT, int N, const float* modl, int shi, float* bias, int r0, int r1, int lane) {
    f32x4 sh[NB][4];
#pragma unroll
    for (int b = 0; b < NB; ++b)
#pragma unroll
        for (int q = 0; q < 4; ++q) sh[b][q] = *((const f32x4*)(modl + (size_t)b * 6144 + shi * 1024 + lane * 16) + q);
    v4u w0 = *(const v4u*)(WT + (size_t)r0 * 1024 + lane * 16), w1 = *(const v4u*)(WT + (size_t)r0 * 1024 + lane * 16 + 8);
    for (int it = r0; it < r1; ++it) {
        const int nx = it + 1 < r1 ? it + 1 : it;
        const v4u n0 = *(const v4u*)(WT + (size_t)nx * 1024 + lane * 16), n1 = *(const v4u*)(WT + (size_t)nx * 1024 + lane * 16 + 8);
        float wf[16];
#pragma unroll
        for (int q = 0; q < 4; ++q) { wf[2 * q] = __builtin_bit_cast(float, w0[q] << 16); wf[2 * q + 1] = __builtin_bit_cast(float, w0[q] & 0xffff0000u);
            wf[8 + 2 * q] = __builtin_bit_cast(float, w1[q] << 16); wf[8 + 2 * q + 1] = __builtin_bit_cast(float, w1[q] & 0xffff0000u); }
        float s[NB];
#pragma unroll
        for (int b = 0; b < NB; ++b) { s[b] = 0.f;
#pragma unroll
            for (int q = 0; q < 4; ++q) s[b] += (sh[b][q].x * wf[4 * q] + sh[b][q].y * wf[4 * q + 1]) + (sh[b][q].z * wf[4 * q + 2] + sh[b][q].w * wf[4 * q + 3]); }
#pragma unroll
        for (int o = 1; o < 64; o <<= 1)
#pragma unroll
            for (int b = 0; b < NB; ++b) s[b] += __builtin_bit_cast(float, __builtin_amdgcn_ds_bpermute((lane ^ o) << 2, __builtin_bit_cast(int, s[b])));
        if (lane < NB) { float v = s[0];
#pragma unroll
            for (int b = 1; b < NB; ++b) v = lane == b ? s[b] : v;
            bias[(size_t)lane * N + it] = v; }
        w0 = n0; w1 = n1;
    }
}

#define XB_XCNT(j)  (256  + 64 * (j))
#define XB_XSUB(j)  (1280 + 64 * (j))
#define XB_XGEN(j)  (2304 + 64 * (j))
#define XB_TOP      3328
#define XB_TOPGEN   3392
__device__ __forceinline__ unsigned xb_ld(unsigned* p)              { return __hip_atomic_load(p, __ATOMIC_RELAXED, __HIP_MEMORY_SCOPE_AGENT); }
__device__ __forceinline__ unsigned xb_add(unsigned* p, unsigned v) { return __hip_atomic_fetch_add(p, v, __ATOMIC_RELAXED, __HIP_MEMORY_SCOPE_AGENT); }
__device__ __forceinline__ void grid_bar(unsigned* bar, unsigned x, volatile LAS unsigned* st, unsigned G, int wave) {
    asm volatile("s_waitcnt vmcnt(0) lgkmcnt(0)" ::: "memory");
    __syncthreads();
    if (wave == 0) {
        if (lane_id_asm() == 0) {
            unsigned nloc = st[0], nx = st[1];
            if (nloc == 0u) {
                for (;;) { unsigned sum = 0u, cnt = 0u, mine = 0u;
#pragma unroll
                    for (unsigned jj = 0; jj < 16; ++jj) { const unsigned c = xb_ld(&bar[XB_XCNT(jj)]); sum += c; cnt += (c > 0u) ? 1u : 0u; mine = (jj == x) ? c : mine; }
                    if (sum == G) { nloc = mine; nx = cnt; break; }
                    __builtin_amdgcn_s_sleep(1); }
                st[0] = nloc; st[1] = nx;
            }
            const unsigned old = xb_add(&bar[XB_XSUB(x)], 1u), gen = old / nloc;
            if (old + 1u == (gen + 1u) * nloc) {
                __builtin_amdgcn_fence(__ATOMIC_RELEASE, "agent");
                asm volatile("s_waitcnt vmcnt(0)" ::: "memory");
                const unsigned og = xb_add(&bar[XB_TOP], 1u), tg = og / nx;
                if (og + 1u == (tg + 1u) * nx) xb_add(&bar[XB_TOPGEN], 1u);
                else while (xb_ld(&bar[XB_TOPGEN]) == tg) __builtin_amdgcn_s_sleep(1);
                __builtin_amdgcn_fence(__ATOMIC_ACQUIRE, "agent");
                xb_add(&bar[XB_XGEN(x)], 1u);
                asm volatile("s_waitcnt vmcnt(0)" ::: "memory");
            } else {
                while (xb_ld(&bar[XB_XGEN(x)]) == gen) __builtin_amdgcn_s_sleep(1);
                __builtin_amdgcn_fence(__ATOMIC_ACQUIRE, "agent");
                asm volatile("s_waitcnt vmcnt(0)" ::: "memory");
            }
        }
    }
    __syncthreads();
}
__global__ void __launch_bounds__(512) mega(Args a) {
    extern __shared__ __attribute__((aligned(16))) unsigned char lds[];
    cg::grid_group grid = cg::this_grid();
    LAS unsigned char* L = (LAS unsigned char*)lds;
    const int tid = threadIdx.x, lane = tid & 63, wave = __builtin_amdgcn_readfirstlane(tid >> 6);
    const int G = gridDim.x, bx = blockIdx.x, vcu = (G % 8 == 0) ? (bx % 8) * (G / 8) + bx / 8 : bx;
    const int gw = vcu * 8 + wave, NGW = G * 8;
    unsigned char* ws = a.ws;
    float* mod = (float*)(ws + WS_MOD);
    float* gmt = (float*)(ws + WS_GM);
    pg8::rss_t* rssb = (pg8::rss_t*)(ws + WS_RSS);
    bf16_t* HA = (bf16_t*)(ws + WS_HA); bf16_t* HB = (bf16_t*)(ws + WS_HB); bf16_t* XB = (bf16_t*)(ws + WS_XB);
    unsigned* barw = (unsigned*)(ws + WS_BAR);
    volatile LAS unsigned* bst = (volatile LAS unsigned*)(L + EPI_LDS_OFF + 8192);
    const unsigned xcc = (unsigned)__builtin_amdgcn_s_getreg((3 << 11) | 20) & 0xFu;
    if (tid == 0) { bst[0] = 0u; bst[1] = 0u; (void)xb_add(&barw[XB_XCNT(xcc)], 1u); }
    __syncthreads();
#define GRID_BAR() grid_bar(barw, xcc, bst, (unsigned)G, wave)

    {
        LAS float* sc = (LAS float*)L;
        LAS float* red = sc + NB * 1024;
        for (int e = tid; e < NB * 1024; e += 512) { const float c = e < 1024 ? a.in[2][e] : a.in[3][e - 1024]; sc[e] = c / (1.0f + expf(-c)); }
        __syncthreads();
        for (int it = G - 1 - bx; it < 4 * 96; it += G) {
            const int i = it / 96, cb = it % 96, ks = tid >> 6, cl = tid & 63;
            const float* w = a.in[5] + ((size_t)i * 1024 + ks * 128) * 6144 + cb * 64 + cl;
            float acc[NB];
#pragma unroll
            for (int b = 0; b < NB; ++b) acc[b] = 0.f;
#pragma unroll 16
            for (int k = 0; k < 128; ++k) { const float wv = w[(size_t)k * 6144];
#pragma unroll
                for (int b = 0; b < NB; ++b) acc[b] += sc[b * 1024 + ks * 128 + k] * wv; }
#pragma unroll
            for (int b = 0; b < NB; ++b) red[(ks * NB + b) * 64 + cl] = acc[b];
            __syncthreads();
            for (int e = tid; e < NB * 64; e += 512) { const int b = e >> 6, c2 = e & 63; float s = a.in[6][i * 6144 + cb * 64 + c2];
#pragma unroll
                for (int k2 = 0; k2 < 8; ++k2) s += red[(k2 * NB + b) * 64 + c2];
                mod[((size_t)i * NB + b) * 6144 + cb * 64 + c2] = s; }
            __syncthreads();
        }
        for (int it = bx; it < 128; it += G) ssm_build(a, it >> 6, it & 63, L, ws);
        LAS float* scr = (LAS float*)(L + wave * 16384);
        for (int it = gw; it < 22528; it += NGW) {
            int r = it;
            if (r < 1536) { const int j = r / 768; transpose_item(a.in[7] + (size_t)j * 1024 * 1536, 1024, 1536, (bf16_t*)(ws + WS_WQKV) + (size_t)j * 1536 * 1024, 1, 0, scr, r % 768, lane); continue; } r -= 1536;
            if (r < 1024) { const int j = r / 512; transpose_item(a.in[10] + (size_t)j * 1024 * 1024, 1024, 1024, (bf16_t*)(ws + WS_WO) + (size_t)j * 1024 * 1024, 0, 0, scr, r % 512, lane); continue; } r -= 1024;
            if (r < 1024) { const int j = r / 512; transpose_item(a.in[11] + (size_t)j * 1024 * 1024, 1024, 1024, (bf16_t*)(ws + WS_WIN) + (size_t)j * 1024 * 1024, 0, 0, scr, r % 512, lane); continue; } r -= 1024;
            if (r < 2048) { const int j = r / 1024; transpose_item(a.in[20] + (size_t)j * 1024 * 2048, 1024, 2048, (bf16_t*)(ws + WS_WGLU) + (size_t)j * 2048 * 1024, 2, 1024, scr, r % 1024, lane); continue; } r -= 2048;
            if (r < 11264) { const int j = r / 2816; transpose_item(a.in[21] + (size_t)j * 1024 * 5632, 1024, 5632, (bf16_t*)(ws + WS_WGU) + (size_t)j * 5632 * 1024, 2, 2816, scr, r % 2816, lane); continue; } r -= 11264;
            { const int j = r / 1408; transpose_item(a.in[22] + (size_t)j * 2816 * 1024, 2816, 1024, (bf16_t*)(ws + WS_WDN) + (size_t)j * 1024 * 2816, 0, 0, scr, r % 1408, lane); }
        }
        { f32x4* z = (f32x4*)(ws + WS_RSS); const f32x4 zero = {0.f, 0.f, 0.f, 0.f}; for (int e = bx * 512 + tid; e < 9 * TT / 2; e += G * 512) z[e] = zero; }
    }
    grid.sync();

    {
        for (int e = bx * 512 + tid; e < 4 * 2 * NB * 1024; e += G * 512) { const int c = e & 1023, b = (e >> 10) % NB, iw = e / (NB * 1024), i = iw >> 1, w = iw & 1;
            gmt[e] = a.in[4][(size_t)iw * 1024 + c] * (1.0f + mod[((size_t)i * NB + b) * 6144 + (w ? 4 : 1) * 1024 + c]); }
        {
            for (int ch = gw; ch < 3456; ch += NGW) {
                int r = ch * 8;
                if (r < 3072) { const int j = r / 1536, rr = r % 1536; bias_rows((const bf16_t*)(ws + WS_WQKV) + (size_t)j * 1536 * 1024, 1536, mod + (size_t)(2 * j) * NB * 6144, 0, (float*)(ws + WS_BQKV) + (size_t)j * NB * 1536, rr, rr + 8, lane); continue; } r -= 3072;
                if (r < 2048) { const int j = r / 1024, rr = r % 1024; bias_rows((const bf16_t*)(ws + WS_WIN) + (size_t)j * 1024 * 1024, 1024, mod + (size_t)(2 * j + 1) * NB * 6144, 0, (float*)(ws + WS_BU) + (size_t)j * NB * 1024, rr, rr + 8, lane); continue; } r -= 2048;
                { const int i = r / 5632, rr = r % 5632; bias_rows((const bf16_t*)(ws + WS_WGU) + (size_t)i * 5632 * 1024, 5632, mod + (size_t)i * NB * 6144, 3, (float*)(ws + WS_BGU) + (size_t)i * NB * 5632, rr, rr + 8, lane); }
            }
        }
        init_rows(a, a.in[4], mod, HA, XB, rssb, gw, NGW);
    }
    GRID_BAR();

#pragma unroll 1
    for (int i = 0; i < 4; ++i) {
        const int j = i >> 1;
        const float* modl = mod + (size_t)i * NB * 6144;
        if ((i & 1) == 0) {
            bf16_t* QKV = (bf16_t*)(ws + WS_QKV);
            {
                pg8::Gemm g{HA, (const bf16_t*)(ws + WS_WQKV) + (size_t)j * 1536 * 1024, TT, NQKV, DM, 0, 0, 0}; pg8::Order S; S.init(TT, NQKV, 1, G, bx);
                pg8::EpiQKV E{QKV, a.in[8] + j * 128, a.in[9] + j * 128, (LAS float*)(L + EPI_LDS_OFF), rssb + (size_t)(2 * i) * TT, (const float*)(ws + WS_BQKV) + (size_t)j * NB * 1536};
                pg8::gemm_phase<pg8::EpiQKV, pg8::Order, true, true>(L, g, S, E, wave);
            }
            GRID_BAR();
            {
                int vcu2 = vcu; asm volatile("" : "+s"(vcu2));
                for (int id = vcu2; id < 2560; id += G) {
                    int qh, kv, row0, kvrow0, seq;
                    if (id < 512) { kv = id >> 8; const int rem = id & 255; qh = kv * 4 + (rem >> 6); kvrow0 = 0; row0 = (rem & 63) * 256; seq = LP; }
                    else { const int id2 = id - 512, gg = id2 >> 7, u = id2 & 127; kv = gg & 1; qh = kv * 4 + (u >> 5); kvrow0 = LP + (gg >> 1) * LS; row0 = kvrow0 + (u & 31) * 256; seq = LS; }
                    attn::attn_dense_body<attn::bf16>((const attn::bf16*)QKV + (size_t)row0 * 1536 + qh * 128, (const attn::bf16*)QKV + (size_t)kvrow0 * 1536 + 1024 + kv * 128,
                                                      (const attn::bf16*)QKV + (size_t)kvrow0 * 1536 + 1280 + kv * 128, HB + (size_t)row0 * DM + qh * 128, seq, (char*)lds, wave);
                    __syncthreads();
                }
            }
            GRID_BAR();
            {
                pg8::Gemm g{HB, (const bf16_t*)(ws + WS_WO) + (size_t)j * 1024 * 1024, TT, DM, DM, 0, 0, 0}; pg8::Order S; S.init(TT, DM, 1, G, bx);
                pg8::EpiRes E{XB, modl + 2 * 1024, gmt + (size_t)(2 * i + 1) * NB * 1024, HA, rssb + (size_t)(2 * i + 1) * TT};
            pg8::gemm_phase<pg8::EpiRes, pg8::Order, true, true>(L, g, S, E, wave);
            }
            GRID_BAR();
        } else {
            bf16_t* A2 = (bf16_t*)(ws + WS_A2); float* EE = (float*)(ws + WS_E);
            const bf16_t* SM = (const bf16_t*)(ws + WS_SSM + (size_t)j * 64 * MiB);
            {
                pg8::Gemm g{HA, (const bf16_t*)(ws + WS_WIN) + (size_t)j * 1024 * 1024, TT, DM, DM, 0, 0, 0}; pg8::Order S; S.init(TT, DM, 1, G, bx);
                pg8::EpiU E{A2, rssb + (size_t)(2 * i) * TT, (const float*)(ws + WS_BU) + (size_t)j * NB * 1024};
                pg8::gemm_phase<pg8::EpiU, pg8::Order, true, true>(L, g, S, E, wave);
            }
            GRID_BAR();
            {
                pg8::Gemm g{A2, SM + 512 * 768, NCH, 256, 512, (size_t)NCH * 768 * 2, MiB, 768}; pg8::Order S; S.init(NCH, 256, 64, G, bx);
                pg8::EpiE E{EE};
                pg8::gemm_phase<pg8::EpiE, pg8::Order, true, true>(L, g, S, E, wave);
            }
            GRID_BAR();
            {
                const f32x2* lam32 = (const f32x2*)(ws + WS_LAM);
                const int lane = lane_id_asm();
                int gw2 = gw; asm volatile("" : "+s"(gw2));
                for (int it = gw2; it < NB * 128; it += NGW) {
                    const int seq = it >> 7, rem = it & 127, gg = rem >> 1, dir = rem & 1;
                    const int nc = seq == 0 ? LP / 32 : LS / 32, c0 = seq == 0 ? 0 : LP / 32 + (seq - 1) * (LS / 32);
                    const f32x2 Lm = lam32[((j * 64 + gg) * 2 + dir) * 64 + lane];
                    const float* __restrict__ Eb = EE + ((size_t)gg * NCH + c0) * 256 + dir * 128 + lane;
                    bf16_t* __restrict__ Sb = A2 + ((size_t)gg * NCH + c0) * 768 + 512 + dir * 128 + lane;
                    float sr = 0.f, si = 0.f;
                    const long cs = dir ? -1 : 1; const long cstart = dir ? nc - 1 : 0;
#pragma unroll 1
                    for (int cb = 0; cb < nc; cb += 64) {
                        float er[64], ei[64];
                        const float* ep = Eb + (cstart + cs * cb) * 256; bf16_t* sp = Sb + (cstart + cs * cb) * 768;
#pragma unroll
                        for (int k = 0; k < 64; ++k) { er[k] = ep[cs * k * 256]; ei[k] = ep[cs * k * 256 + 64]; }
                        asm volatile("" ::: "memory");
#pragma unroll
                        for (int k = 0; k < 64; ++k) {
                            sp[cs * k * 768] = (bf16_t)f2bf(sr); sp[cs * k * 768 + 64] = (bf16_t)f2bf(si);
                            const float nr = Lm.x * sr - Lm.y * si + er[k], ni = Lm.x * si + Lm.y * sr + ei[k]; sr = nr; si = ni; }
                    }
                }
            }
            GRID_BAR();
            {
                pg8::Gemm g{A2, SM, NCH, 512, 768, (size_t)NCH * 768 * 2, MiB, 768}; pg8::Order S; S.init(NCH, 512, 64, G, bx);
                pg8::EpiS2 E{HB};
                pg8::gemm_phase<pg8::EpiS2, pg8::Order, true, true>(L, g, S, E, wave);
            }
            GRID_BAR();
            {
                pg8::Gemm g{HB, (const bf16_t*)(ws + WS_WGLU) + (size_t)j * 2048 * 1024, TT, 2048, DM, 0, 0, 0}; pg8::Order S; S.init(TT, 2048, 1, G, bx);
                pg8::EpiGluRes E{XB, modl + 2 * 1024, gmt + (size_t)(2 * i + 1) * NB * 1024, HA, rssb + (size_t)(2 * i + 1) * TT};
            pg8::gemm_phase<pg8::EpiGluRes, pg8::Order, true, true>(L, g, S, E, wave);
            }
            GRID_BAR();
        }
        bf16_t* ACT = (bf16_t*)(ws + WS_ACT);
        {
            pg8::Gemm g{HA, (const bf16_t*)(ws + WS_WGU) + (size_t)i * 5632 * 1024, TT, 5632, DM, 0, 0, 0}; pg8::Order S; S.init(TT, 5632, 1, G, bx);
            pg8::EpiGU E{ACT, rssb + (size_t)(2 * i + 1) * TT, (const float*)(ws + WS_BGU) + (size_t)i * NB * 5632};
            pg8::gemm_phase<pg8::EpiGU, pg8::Order, true, true>(L, g, S, E, wave);
        }
        GRID_BAR();
        {
            pg8::Gemm g{ACT, (const bf16_t*)(ws + WS_WDN) + (size_t)i * 1024 * 2816, TT, DM, DFF, 0, 0, 0}; pg8::Order S; S.init(TT, DM, 1, G, bx);
            pg8::EpiRes E{XB, modl + 5 * 1024, i < 3 ? gmt + (size_t)(2 * i + 2) * NB * 1024 : (const float*)nullptr, HA, rssb + (size_t)(2 * i + 2) * TT};
            pg8::gemm_phase<pg8::EpiRes, pg8::Order, true, true>(L, g, S, E, wave);
        }
        GRID_BAR();
    }
    { const int lane = lane_id_asm(), fr = lane & 15, fq = lane >> 4; const pg8::rss_t* rs8 = rssb + (size_t)8 * TT;
    for (int gi = gw; gi < TT / 16; gi += NGW) {
        const int row = gi * 16 + fr, pm = gi >> 4, am = ((gi >> 3) & 1) * 4 + (gi & 3), wr = (gi >> 2) & 1;
        const float rstd = 1.0f / sqrtf((float)rs8[row] * (1.0f / (1048576.0f * DM)) + EPS);
#pragma unroll 1
        for (int ib = 0; ib < 32; ib += 8) {
            pg8::u32x4 w[8]; f32x4 g0[8], g1[8];
#pragma unroll
            for (int k = 0; k < 8; ++k) { const int it = ib + k, pnq = it >> 2, wc = it & 3, c0 = pnq * 128 + wc * 32 + fq * 8;
                w[k] = *(const pg8::u32x4*)(XB + ((size_t)((((pm * 8 + pnq) * 2 + wr) * 4 + wc) * 8 + am) * 64 + lane) * 8);
                g0[k] = *(const f32x4*)(a.in[23] + c0); g1[k] = *(const f32x4*)(a.in[23] + c0 + 4); }
            asm volatile("" ::: "memory");
#pragma unroll
            for (int k = 0; k < 8; ++k) { const int it = ib + k, pnq = it >> 2, wc = it & 3, c0 = pnq * 128 + wc * 32 + fq * 8;
                f32x4 v0, v1; pg8::bf8_to_f32(w[k], v0, v1);
                __builtin_nontemporal_store((v0 * rstd) * g0[k], (f32x4*)(a.out + (size_t)row * DM + c0)); __builtin_nontemporal_store((v1 * rstd) * g1[k], (f32x4*)(a.out + (size_t)row * DM + c0 + 4)); }
        }
    }
    }
}

extern "C" void kernel_launch(void* const* d_in, const int* in_sizes, int n_in, void* d_out, int out_size, void* d_ws, size_t ws_size, hipStream_t stream) {
    static int grid = 0;
    if (grid == 0) {
        if (n_in != 24 || out_size != TT * DM || ws_size < WS_NEED) { fprintf(stderr, "kernel_launch: unexpected shapes: n_in %d out %d ws %zu (need %zu)\n", n_in, out_size, ws_size, (size_t)WS_NEED); grid = -1; return; }
        int dev = 0, cus = 0, per_cu = 0;
        if (hipGetDevice(&dev) != hipSuccess || hipDeviceGetAttribute(&cus, hipDeviceAttributeMultiprocessorCount, dev) != hipSuccess) { grid = -1; return; }
        if (hipFuncSetAttribute((const void*)mega, hipFuncAttributeMaxDynamicSharedMemorySize, LDS_BYTES) != hipSuccess) { fprintf(stderr, "kernel_launch: hipFuncSetAttribute failed\n"); grid = -1; return; }
        if (hipOccupancyMaxActiveBlocksPerMultiprocessor(&per_cu, (const void*)mega, 512, LDS_BYTES) != hipSuccess || per_cu < 1) { fprintf(stderr, "kernel_launch: occupancy query says %d\n", per_cu); (void)hipGetLastError(); }
        grid = cus;
    }
    if (grid < 0) return;
    if (hipMemsetAsync((char*)d_ws + WS_BAR, 0, 16384, stream) != hipSuccess) { fprintf(stderr, "kernel_launch: memset failed\n"); return; }
    Args a{};
    for (int i = 0; i < 24; ++i) a.in[i] = (const float*)d_in[i];
    a.out = (float*)d_out; a.ws = (unsigned char*)d_ws;
    void* args[] = {&a};
    hipError_t e = hipLaunchCooperativeKernel((const void*)mega, dim3(grid), dim3(512), args, LDS_BYTES, stream);
    if (e != hipSuccess) fprintf(stderr, "cooperative launch failed: %s (grid %d)\n", hipGetErrorString(e), grid);
}
```

```cpp
#include <hip/hip_runtime.h>
#include <hip/hip_bf16.h>
#include <hip/hip_cooperative_groups.h>
#include <cstdio>
#include <cstdint>
#include <cmath>
namespace cg = cooperative_groups;

constexpr int DM = 1024, LP = 16384, NSS = 8, LS = 8192, TT = LP + NSS * LS, NB = 9, DFF = 2816, NQKV = 1536;
constexpr int NCH = TT / 32;
constexpr float EPS = 1e-6f;
constexpr size_t MiB = 1u << 20;
constexpr size_t WS_MOD = 0, WS_LAM = 1 * MiB, WS_GM = 1 * MiB + 256 * 1024, WS_BQKV = 2 * MiB, WS_BU = 2 * MiB + 128 * 1024, WS_BGU = 2 * MiB + 256 * 1024, WS_RSS = 984 * MiB;
constexpr size_t WS_WQKV = 8 * MiB, WS_WO = 14 * MiB, WS_WIN = 18 * MiB, WS_WGLU = 22 * MiB, WS_WGU = 30 * MiB, WS_WDN = 74 * MiB;
constexpr size_t WS_SSM = 96 * MiB, WS_HA = 224 * MiB, WS_XB = 384 * MiB, WS_BIG = 544 * MiB;
constexpr size_t WS_QKV = WS_BIG, WS_ACT = WS_BIG, WS_A2 = WS_BIG, WS_E = WS_BIG + 240 * MiB, WS_HB = WS_BIG + 240 * MiB, WS_END = WS_BIG + 440 * MiB;
static_assert(WS_END == 984 * MiB && WS_RSS + 9ull * TT * 8 <= 1024 * MiB, "ws map");
constexpr size_t WS_NEED = 1024 * MiB;
constexpr size_t WS_BAR = 896 * 1024;
constexpr int LDS_BYTES = 147456, EPI_LDS_OFF = 131072;

__device__ __forceinline__ int lane_id_asm() { int l; asm volatile("v_mbcnt_lo_u32_b32 %0, -1, 0\n\tv_mbcnt_hi_u32_b32 %0, -1, %0" : "=v"(l)); return l; }

namespace pg8 {
#define PG8_LAS __attribute__((address_space(3)))
typedef unsigned short bf16_t;
typedef short bf16x8 __attribute__((ext_vector_type(8)));
typedef float f32x4 __attribute__((ext_vector_type(4)));
typedef unsigned u32x4 __attribute__((ext_vector_type(4)));
constexpr int BM = 256, BK = 64, HALF = 128, HTB = HALF * BK * 2  , STAGE_BYTES = 8 * HTB, NXCD = 8, WGM = 8;

__host__ __device__ __forceinline__ int lds_byte(int r, int c) { const int st = (r >> 4) * 2 + (c >> 5), rr = r & 15, cc = c & 31, ob = rr * 64 + cc * 2; return st * 1024 + (ob ^ (((ob >> 9) & 1) << 5)); }
__host__ __device__ __forceinline__ void stage_rc(int b, int& R, int& C) { const int st = b / 1024, sb = b % 1024, swz = sb ^ (((sb >> 9) & 1) << 5); R = (st >> 1) * 16 + swz / 64; C = (st & 1) * 32 + (swz % 64) / 2; }
__host__ __device__ __forceinline__ int perm32(int rho) { const int n = rho >> 4, i = rho & 15; return 8 * (i >> 2) + 4 * n + (i & 3); }

struct Unit { int pm, pn, gb; };
struct Gemm { const bf16_t* A; const bf16_t* Bt; int M, N, K; size_t strideA, strideB; int lda; };

struct Order {
    int nM, nN, nwg, nb, G, c;
    __device__ __forceinline__ void init(int M, int N, int nb_, int G_, int c_) { nM = M / BM; nN = N / BM; nwg = nM * nN; nb = nb_; G = G_; c = c_; asm volatile("" : "+s"(c)); }
    __device__ __forceinline__ bool next(int i, Unit& u) const {
        if (nb > 1 && (G & 7) == 0 && (nb & 7) == 0) {
            const int xcd = c & 7, r = c >> 3, per = G >> 3, j = i * per + r, tot = (nb >> 3) * nwg;
            if (j >= tot) return false;
            const int gl = j / nwg, wg = j - gl * nwg;
            u.gb = gl * 8 + xcd; u.pm = wg / nN; u.pn = wg - u.pm * nN; return true;
        }
        const long L = (long)i * G + c; if (L >= (long)nwg * nb) return false;
        u.gb = (int)(L / nwg); int wgid = (int)(L - (long)u.gb * nwg);
        { const int q = nwg / NXCD, r = nwg % NXCD, xcd = wgid % NXCD, off = wgid / NXCD; wgid = (xcd < r ? xcd * (q + 1) : r * (q + 1) + (xcd - r) * q) + off; }
        const int nig = WGM * nN, gid = wgid / nig, fm = gid * WGM, gsz = (nM - fm) < WGM ? (nM - fm) : WGM;
        u.pm = fm + ((wgid % nig) % gsz); u.pn = (wgid % nig) / gsz; return true;
    }
    __device__ __forceinline__ void a_ready(const Unit&) const {}
    __device__ __forceinline__ void done(const Unit&) const {}
};

__device__ __forceinline__ unsigned cvt_pk_bf16(float lo, float hi) { unsigned r; asm volatile("v_cvt_pk_bf16_f32 %0, %1, %2" : "=v"(r) : "v"(lo), "v"(hi)); return r; }
__device__ __forceinline__ float sigmoid_f(float x) { return __builtin_amdgcn_rcpf(1.0f + __builtin_amdgcn_exp2f(-1.4426950408889634f * x)); }
__device__ __forceinline__ float gelu_tanh_f(float x) { const float u = 0.7978845608028654f * (x + 0.044715f * x * x * x); return x * sigmoid_f(2.0f * u); }
__device__ __forceinline__ int batch_of_tile(int pm) { return pm < 64 ? 0 : 1 + ((pm - 64) >> 5); }
constexpr int XD = 1024, XNB_STRIDE = 6144, XT = 81920, XNCH = 2560, XDFF = 2816;

typedef unsigned long long rss_t;
__device__ __forceinline__ rss_t rss_fix(float ss) { return (rss_t)(ss * 1048576.0f + 0.5f); }
__device__ __forceinline__ float rstd_of(const rss_t* rss, size_t row) { return __builtin_amdgcn_rsqf((float)rss[row] * (1.0f / (1048576.0f * 1024.0f)) + 1e-6f); }
__device__ __forceinline__ float bperm_f(int srclane, float v) { return __builtin_bit_cast(float, __builtin_amdgcn_ds_bpermute(srclane << 2, __builtin_bit_cast(int, v))); }

typedef _Float16 h16x2 __attribute__((ext_vector_type(2)));
typedef float f32x2_t __attribute__((ext_vector_type(2)));
__device__ __forceinline__ unsigned cvt_h(float f) { unsigned h; asm volatile("v_cvt_f16_f32 %0, %1" : "=v"(h) : "v"(f)); return h; }
__device__ __forceinline__ float cvt_f(unsigned h) { float f; asm volatile("v_cvt_f32_f16 %0, %1" : "=v"(f) : "v"(h)); return f; }
__device__ __forceinline__ float cvt_f_hi(unsigned h) { float f; asm volatile("v_cvt_f32_f16_sdwa %0, %1 dst_sel:DWORD dst_unused:UNUSED_PAD src0_sel:WORD_1" : "=v"(f) : "v"(h)); return f; }
__device__ __forceinline__ unsigned pk_h2(float a, float b) { unsigned r; const unsigned ha = cvt_h(a), hb = cvt_h(b); asm volatile("v_pack_b32_f16 %0, %1, %2" : "=v"(r) : "v"(ha), "v"(hb)); return r; }
__device__ __forceinline__ void bf8_to_f32(const u32x4 w, f32x4& lo, f32x4& hi) {
    lo[0] = cvt_f(w.x); lo[1] = cvt_f_hi(w.x); lo[2] = cvt_f(w.y); lo[3] = cvt_f_hi(w.y); hi[0] = cvt_f(w.z); hi[1] = cvt_f_hi(w.z); hi[2] = cvt_f(w.w); hi[3] = cvt_f_hi(w.w);
}
__device__ __forceinline__ u32x4 f32_to_h8(const f32x4 v0, const f32x4 v1) { u32x4 w; w.x = pk_h2(v0[0], v0[1]); w.y = pk_h2(v0[2], v0[3]); w.z = pk_h2(v1[0], v1[1]); w.w = pk_h2(v1[2], v1[3]); return w; }
__device__ __forceinline__ u32x4 f32_to_bf8(const f32x4 v0, const f32x4 v1) { u32x4 w; w.x = cvt_pk_bf16(v0[0], v0[1]); w.y = cvt_pk_bf16(v0[2], v0[3]); w.z = cvt_pk_bf16(v1[0], v1[1]); w.w = cvt_pk_bf16(v1[2], v1[3]); return w; }
__device__ __forceinline__ f32x2_t sigmoid_pk(const f32x2_t x) { const f32x2_t a = x * (-1.4426950408889634f); f32x2_t e; e.x = __builtin_amdgcn_exp2f(a.x); e.y = __builtin_amdgcn_exp2f(a.y);
    const f32x2_t d = e + 1.0f; f32x2_t r; r.x = __builtin_amdgcn_rcpf(d.x); r.y = __builtin_amdgcn_rcpf(d.y); return r; }
__device__ __forceinline__ f32x2_t gelu_tanh_pk(const f32x2_t x) {
    const f32x2_t p = (x * x) * 0.044715f + 1.0f, a = (x * (-2.3022081985f)) * p; f32x2_t e; e.x = __builtin_amdgcn_exp2f(a.x); e.y = __builtin_amdgcn_exp2f(a.y);
    const f32x2_t d = e + 1.0f; f32x2_t r; r.x = __builtin_amdgcn_rcpf(d.x); r.y = __builtin_amdgcn_rcpf(d.y); return x * r; }
struct EpiRes {
    static constexpr bool PERM = true, AFTER_DRAIN = false, PREFETCH = false;
    bf16_t* x; const float* gate; const float* gm; bf16_t* HA; rss_t* rss;
    __device__ __forceinline__ void operator()(const f32x4 (&acc)[2][2][4][2], const Unit& u, int wr, int wc, int fr, int fq) const {
        const int b = batch_of_tile(u.pm), col0 = u.pn * BM + wc * 32 + 8 * fq, ln = fq * 16 + fr;
        const float* gp = gate + (size_t)b * XNB_STRIDE + col0; const float* mp = gm ? gm + (size_t)b * XD + col0 : nullptr;
        bf16_t* xb = x + ((size_t)((((u.pm * 8 + 2 * u.pn) * 2 + wr) * 4 + wc) * 8) * 64 + ln) * 8;
#pragma unroll
        for (int ai = 0; ai < 2; ++ai) {
            u32x4 xs[4][2];
#pragma unroll
            for (int m = 0; m < 4; ++m)
#pragma unroll
                for (int bj = 0; bj < 2; ++bj) xs[m][bj] = *(const u32x4*)(xb + (size_t)bj * 32768 + (ai * 4 + m) * 512);
            f32x4 gv[2][2], mv[2][2];
#pragma unroll
            for (int bj = 0; bj < 2; ++bj)
#pragma unroll
                for (int n = 0; n < 2; ++n) { gv[bj][n] = *(const f32x4*)(gp + bj * HALF + 4 * n); if (mp) mv[bj][n] = *(const f32x4*)(mp + bj * HALF + 4 * n); }
#pragma unroll
            for (int m = 0; m < 4; ++m) { const size_t row = (size_t)(u.pm * BM + ai * HALF + wr * 64 + m * 16 + fr); float ss = 0.f;
#pragma unroll
                for (int bj = 0; bj < 2; ++bj) {
                    f32x4 v0, v1; bf8_to_f32(xs[m][bj], v0, v1);
                    v0 = v0 + gv[bj][0] * acc[ai][bj][m][0]; v1 = v1 + gv[bj][1] * acc[ai][bj][m][1];
                    *(u32x4*)(xb + (size_t)bj * 32768 + (ai * 4 + m) * 512) = f32_to_h8(v0, v1);
                    ss += (v0[0] * v0[0] + v0[1] * v0[1]) + (v0[2] * v0[2] + v0[3] * v0[3]) + (v1[0] * v1[0] + v1[1] * v1[1]) + (v1[2] * v1[2] + v1[3] * v1[3]);
                    if (mp) *(u32x4*)(HA + row * XD + col0 + bj * HALF) = f32_to_bf8(v0 * mv[bj][0], v1 * mv[bj][1]); }
                ss += bperm_f(ln ^ 16, ss); ss += bperm_f(ln ^ 32, ss);
                if (fq == 0) atomicAdd(rss + row, rss_fix(ss)); }
            asm volatile("" ::: "memory"); }
    }
};
struct EpiGU {
    static constexpr bool PERM = true, AFTER_DRAIN = false, PREFETCH = false;
    bf16_t* act; const rss_t* rss; const float* bias;
    __device__ __forceinline__ void operator()(const f32x4 (&acc)[2][2][4][2], const Unit& u, int wr, int wc, int fr, int fq) const {
        const int b = batch_of_tile(u.pm), col0 = u.pn * HALF + wc * 32 + 8 * fq;
        const float* bp = bias + (size_t)b * 5632 + u.pn * BM + wc * 32 + 8 * fq;
        const f32x4 bg0 = *(const f32x4*)bp, bg1 = *(const f32x4*)(bp + 4), bu0 = *(const f32x4*)(bp + HALF), bu1 = *(const f32x4*)(bp + HALF + 4);
        float rsv[2][4];
#pragma unroll
        for (int ai = 0; ai < 2; ++ai)
#pragma unroll
            for (int m = 0; m < 4; ++m) rsv[ai][m] = rstd_of(rss, (size_t)(u.pm * BM + ai * HALF + wr * 64 + m * 16 + fr));
#pragma unroll
        for (int ai = 0; ai < 2; ++ai)
#pragma unroll
            for (int m = 0; m < 4; ++m) { const size_t row = (size_t)(u.pm * BM + ai * HALF + wr * 64 + m * 16 + fr); const float rs = rsv[ai][m];
                u32x4 w;
#pragma unroll
                for (int n = 0; n < 2; ++n)
#pragma unroll
                    for (int h = 0; h < 2; ++h) {
                        const f32x2_t ag = {acc[ai][0][m][n][2 * h], acc[ai][0][m][n][2 * h + 1]}, au = {acc[ai][1][m][n][2 * h], acc[ai][1][m][n][2 * h + 1]};
                        const f32x4 bgv = n ? bg1 : bg0, buv = n ? bu1 : bu0;
                        const f32x2_t bg = {bgv[2 * h], bgv[2 * h + 1]}, bu = {buv[2 * h], buv[2 * h + 1]};
                        const f32x2_t g = ag * rs + bg, up = au * rs + bu, ea = g * (-1.4426950408889634f);
                        f32x2_t ex; ex.x = __builtin_amdgcn_exp2f(ea.x); ex.y = __builtin_amdgcn_exp2f(ea.y);
                        const f32x2_t d = ex + 1.0f; f32x2_t rc; rc.x = __builtin_amdgcn_rcpf(d.x); rc.y = __builtin_amdgcn_rcpf(d.y);
                        const f32x2_t o = (g * up) * rc;
                        w[n * 2 + h] = cvt_pk_bf16(o.x, o.y); }
                __builtin_nontemporal_store(w, (u32x4*)(act + row * XDFF + col0)); }
    }
};
struct EpiGluRes {
    static constexpr bool PERM = true, AFTER_DRAIN = false, PREFETCH = false;
    bf16_t* x; const float* gate; const float* gm; bf16_t* HA; rss_t* rss;
    __device__ __forceinline__ void operator()(const f32x4 (&acc)[2][2][4][2], const Unit& u, int wr, int wc, int fr, int fq) const {
        const int b = batch_of_tile(u.pm), col0 = u.pn * HALF + wc * 32 + 8 * fq, ln = fq * 16 + fr;
        const float* gp = gate + (size_t)b * XNB_STRIDE + col0; const float* mp = gm + (size_t)b * XD + col0;
        bf16_t* xb = x + ((size_t)((((u.pm * 8 + u.pn) * 2 + wr) * 4 + wc) * 8) * 64 + ln) * 8;
        u32x4 xs[2][4];
#pragma unroll
        for (int ai = 0; ai < 2; ++ai)
#pragma unroll
            for (int m = 0; m < 4; ++m) xs[ai][m] = *(const u32x4*)(xb + (ai * 4 + m) * 512);
        const f32x4 g0 = *(const f32x4*)gp, g1 = *(const f32x4*)(gp + 4), m0 = *(const f32x4*)mp, m1 = *(const f32x4*)(mp + 4);
#pragma unroll
        for (int ai = 0; ai < 2; ++ai)
#pragma unroll
            for (int m = 0; m < 4; ++m) { const size_t row = (size_t)(u.pm * BM + ai * HALF + wr * 64 + m * 16 + fr);
                f32x4 v0, v1; bf8_to_f32(xs[ai][m], v0, v1);
#pragma unroll
                for (int h = 0; h < 2; ++h) {
                    const f32x2_t s0 = sigmoid_pk((f32x2_t){acc[ai][1][m][0][2 * h], acc[ai][1][m][0][2 * h + 1]}), s1 = sigmoid_pk((f32x2_t){acc[ai][1][m][1][2 * h], acc[ai][1][m][1][2 * h + 1]});
                    const f32x2_t a0 = {acc[ai][0][m][0][2 * h], acc[ai][0][m][0][2 * h + 1]}, a1 = {acc[ai][0][m][1][2 * h], acc[ai][0][m][1][2 * h + 1]};
                    const f32x2_t q0 = (f32x2_t){v0[2 * h], v0[2 * h + 1]} + ((f32x2_t){g0[2 * h], g0[2 * h + 1]} * a0) * s0, q1 = (f32x2_t){v1[2 * h], v1[2 * h + 1]} + ((f32x2_t){g1[2 * h], g1[2 * h + 1]} * a1) * s1;
                    v0[2 * h] = q0.x; v0[2 * h + 1] = q0.y; v1[2 * h] = q1.x; v1[2 * h + 1] = q1.y; }
                *(u32x4*)(xb + (ai * 4 + m) * 512) = f32_to_h8(v0, v1);
                float ss = (v0[0] * v0[0] + v0[1] * v0[1]) + (v0[2] * v0[2] + v0[3] * v0[3]) + (v1[0] * v1[0] + v1[1] * v1[1]) + (v1[2] * v1[2] + v1[3] * v1[3]);
                *(u32x4*)(HA + row * XD + col0) = f32_to_bf8(v0 * m0, v1 * m1);
                ss += bperm_f(ln ^ 16, ss); ss += bperm_f(ln ^ 32, ss);
                if (fq == 0) atomicAdd(rss + row, rss_fix(ss)); }
    }
};
struct EpiU {
    static constexpr bool PERM = true, AFTER_DRAIN = false, PREFETCH = false;
    bf16_t* A2; const rss_t* rss; const float* bias;
    __device__ __forceinline__ void operator()(const f32x4 (&acc)[2][2][4][2], const Unit& u, int wr, int wc, int fr, int fq) const {
        const int b = batch_of_tile(u.pm); const float* bp = bias + (size_t)b * XD + u.pn * BM + wc * 32 + 8 * fq;
        f32x4 bv[2][2];
#pragma unroll
        for (int bj = 0; bj < 2; ++bj) { bv[bj][0] = *(const f32x4*)(bp + bj * HALF); bv[bj][1] = *(const f32x4*)(bp + bj * HALF + 4); }
        float rsv[2][4];
#pragma unroll
        for (int ai = 0; ai < 2; ++ai)
#pragma unroll
            for (int m = 0; m < 4; ++m) rsv[ai][m] = rstd_of(rss, (size_t)(u.pm * BM + ai * HALF + wr * 64 + m * 16 + fr));
#pragma unroll
        for (int ai = 0; ai < 2; ++ai)
#pragma unroll
            for (int m = 0; m < 4; ++m) { const size_t row = (size_t)(u.pm * BM + ai * HALF + wr * 64 + m * 16 + fr); const float rs = rsv[ai][m];
#pragma unroll
                for (int bj = 0; bj < 2; ++bj) { const int col0 = u.pn * BM + bj * HALF + wc * 32 + 8 * fq;
                    const f32x4 v0 = acc[ai][bj][m][0] * rs + bv[bj][0], v1 = acc[ai][bj][m][1] * rs + bv[bj][1];
                    u32x4 w; w.x = cvt_pk_bf16(v0[0], v0[1]); w.y = cvt_pk_bf16(v0[2], v0[3]); w.z = cvt_pk_bf16(v1[0], v1[1]); w.w = cvt_pk_bf16(v1[2], v1[3]);
                    *(u32x4*)(A2 + ((size_t)(col0 >> 4) * XNCH + (row >> 5)) * 768 + (row & 31) * 16 + (col0 & 15)) = w; } }
    }
};
struct EpiE {
    static constexpr bool PERM = true, AFTER_DRAIN = false, PREFETCH = false;
    float* E;
    __device__ __forceinline__ void operator()(const f32x4 (&acc)[2][2][4][2], const Unit& u, int wr, int wc, int fr, int fq) const {
        const int cb = wc * 32 + 8 * fq;
#pragma unroll
        for (int ai = 0; ai < 2; ++ai)
#pragma unroll
            for (int m = 0; m < 4; ++m) { float* rowp = E + ((size_t)u.gb * XNCH + (size_t)(u.pm * BM + ai * HALF + wr * 64 + m * 16 + fr)) * 256 + cb;
#pragma unroll
                for (int bj = 0; bj < 2; ++bj)
#pragma unroll
                    for (int n = 0; n < 2; ++n) *(f32x4*)(rowp + bj * HALF + 4 * n) = acc[ai][bj][m][n]; }
    }
};
struct EpiS2 {
    static constexpr bool PERM = true, AFTER_DRAIN = false, PREFETCH = false;
    bf16_t* Z;
    __device__ __forceinline__ void operator()(const f32x4 (&acc)[2][2][4][2], const Unit& u, int wr, int wc, int fr, int fq) const {
#pragma unroll
        for (int ai = 0; ai < 2; ++ai)
#pragma unroll
            for (int m = 0; m < 4; ++m) { const size_t row = (size_t)(u.pm * BM + ai * HALF + wr * 64 + m * 16 + fr);
#pragma unroll
                for (int bj = 0; bj < 2; ++bj) { const int col0 = u.pn * BM + bj * HALF + wc * 32 + 8 * fq; u32x4 w;
#pragma unroll
                    for (int n = 0; n < 2; ++n)
#pragma unroll
                        for (int h = 0; h < 2; ++h) { const f32x2_t o = gelu_tanh_pk((f32x2_t){acc[ai][bj][m][n][2 * h], acc[ai][bj][m][n][2 * h + 1]}); w[n * 2 + h] = cvt_pk_bf16(o.x, o.y); }
                    *(u32x4*)(Z + (row * 32 + (size_t)(col0 >> 4)) * XD + u.gb * 16 + (col0 & 15)) = w; } }
    }
};
struct EpiQKV {
    static constexpr bool PERM = true, AFTER_DRAIN = false, PREFETCH = false;
    bf16_t* QKV; const float* qg; const float* kg; PG8_LAS float* P; const rss_t* rss; const float* bias;
    __device__ __forceinline__ void operator()(f32x4 (&acc)[2][2][4][2], const Unit& u, int wr, int wc, int fr, int fq) const {
        const bool nrm = u.pn < 5;
        {
            const int b = batch_of_tile(u.pm); const float* bp = bias + (size_t)b * 1536 + u.pn * BM + wc * 32 + 8 * fq;
            rss_t rv[2][4]; float rsv[2][4];
#pragma unroll
            for (int ai = 0; ai < 2; ++ai)
#pragma unroll
                for (int m = 0; m < 4; ++m) rv[ai][m] = rss[(size_t)(u.pm * BM + ai * HALF + wr * 64 + m * 16 + fr)];
            f32x4 bv[2][2];
#pragma unroll
            for (int bj = 0; bj < 2; ++bj) { bv[bj][0] = *(const f32x4*)(bp + bj * HALF); bv[bj][1] = *(const f32x4*)(bp + bj * HALF + 4); }
            asm volatile("" ::: "memory");
#pragma unroll
            for (int ai = 0; ai < 2; ++ai)
#pragma unroll
                for (int m = 0; m < 4; ++m) rsv[ai][m] = __builtin_amdgcn_rsqf((float)rv[ai][m] * (1.0f / (1048576.0f * 1024.0f)) + 1e-6f);
#pragma unroll
            for (int ai = 0; ai < 2; ++ai)
#pragma unroll
                for (int m = 0; m < 4; ++m) { const float rs = rsv[ai][m];
#pragma unroll
                    for (int bj = 0; bj < 2; ++bj)
#pragma unroll
                        for (int n = 0; n < 2; ++n) acc[ai][bj][m][n] = acc[ai][bj][m][n] * rs + bv[bj][n]; }
        }
        if (nrm) {
#pragma unroll
            for (int ai = 0; ai < 2; ++ai)
#pragma unroll
                for (int m = 0; m < 4; ++m)
#pragma unroll
                    for (int bj = 0; bj < 2; ++bj) { const f32x4 a0 = acc[ai][bj][m][0], a1 = acc[ai][bj][m][1];
                        float s = (a0[0] * a0[0] + a0[1] * a0[1]) + (a0[2] * a0[2] + a0[3] * a0[3]) + (a1[0] * a1[0] + a1[1] * a1[1]) + (a1[2] * a1[2] + a1[3] * a1[3]);
                        { const int ln = fq * 16 + fr; s += __builtin_bit_cast(float, __builtin_amdgcn_ds_bpermute((ln ^ 16) << 2, __builtin_bit_cast(int, s))); s += __builtin_bit_cast(float, __builtin_amdgcn_ds_bpermute((ln ^ 32) << 2, __builtin_bit_cast(int, s))); }
                        if (fq == 0) P[(bj * 256 + ai * HALF + wr * 64 + m * 16 + fr) * 4 + wc] = s; }
        }
        asm volatile("s_waitcnt lgkmcnt(0)" ::: "memory"); __builtin_amdgcn_s_barrier(); asm volatile("" ::: "memory");
        const int col0 = u.pn * BM + wc * 32 + 8 * fq;
        if (nrm) {
            const float* gsrc = (u.pn < 4) ? qg : kg;
            const int dbase = (wc >> 1) * 64 + (wc & 1) * 16 + 4 * fq;
            const f32x4 g1 = *(const f32x4*)(gsrc + dbase), g2 = *(const f32x4*)(gsrc + dbase + 32);
            float inv[4];
#pragma unroll
            for (int e = 0; e < 4; ++e) inv[e] = __builtin_amdgcn_exp2f(-(float)((wc & 1) * 16 + 4 * fq + e) * (13.287712379549449f / 32.0f)) * 0.15915494309189535f;
            const int seq0 = u.pm < 64 ? 0 : 16384 + ((u.pm - 64) >> 5) * 8192;
#pragma unroll
            for (int ai = 0; ai < 2; ++ai)
#pragma unroll
                for (int m = 0; m < 4; ++m) { const int rl = ai * HALF + wr * 64 + m * 16 + fr, row = u.pm * BM + rl, l = row - seq0;
                    const float pos = (float)((wc >> 1) ? (l & 63) : (l >> 6));
                    float cs[4], sn[4];
#pragma unroll
                    for (int e = 0; e < 4; ++e) { float rev = pos * inv[e]; rev = rev - floorf(rev); cs[e] = __builtin_amdgcn_cosf(rev); sn[e] = __builtin_amdgcn_sinf(rev); }
#pragma unroll
                    for (int bj = 0; bj < 2; ++bj) { const f32x4 pp = *(const PG8_LAS f32x4*)(P + (bj * 256 + rl) * 4);
                        const float rstd = __builtin_amdgcn_rsqf(((pp[0] + pp[1]) + (pp[2] + pp[3])) * (1.0f / 128.0f) + 1e-6f);
                        float o1[4], o2[4];
#pragma unroll
                        for (int e = 0; e < 4; ++e) { const float y1 = acc[ai][bj][m][0][e] * rstd * g1[e], y2 = acc[ai][bj][m][1][e] * rstd * g2[e];
                            o1[e] = y1 * cs[e] - y2 * sn[e]; o2[e] = y2 * cs[e] + y1 * sn[e]; }
                        u32x4 w; w.x = cvt_pk_bf16(o1[0], o1[1]); w.y = cvt_pk_bf16(o1[2], o1[3]); w.z = cvt_pk_bf16(o2[0], o2[1]); w.w = cvt_pk_bf16(o2[2], o2[3]);
                        *(u32x4*)(QKV + (size_t)row * 1536 + col0 + bj * HALF) = w; }
                    if ((m & 3) == 3) asm volatile("" ::: "memory"); }
        } else {
#pragma unroll
            for (int ai = 0; ai < 2; ++ai)
#pragma unroll
                for (int m = 0; m < 4; ++m) { const size_t row = (size_t)(u.pm * BM + ai * HALF + wr * 64 + m * 16 + fr);
#pragma unroll
                    for (int bj = 0; bj < 2; ++bj) { const f32x4 v0 = acc[ai][bj][m][0], v1 = acc[ai][bj][m][1];
                        u32x4 w; w.x = cvt_pk_bf16(v0[0], v0[1]); w.y = cvt_pk_bf16(v0[2], v0[3]); w.z = cvt_pk_bf16(v1[0], v1[1]); w.w = cvt_pk_bf16(v1[2], v1[3]);
                        *(u32x4*)(QKV + row * 1536 + col0 + bj * HALF) = w; } }
        }
    }
};

template <class Epi, class Sched, bool ALIGN_EPI = false, bool SP2 = false>
__device__ __forceinline__ void gemm_phase(PG8_LAS unsigned char* lds, const Gemm g, const Sched& S, const Epi& E, const int wave_s) {
    const int lane = lane_id_asm();
    int wid_l = wave_s; asm volatile("" : "+s"(wid_l));
    const int wid = wid_l, tid = wid_l * 64 + lane, wr = wid >> 2, wc = wid & 3, fr = lane & 15, fq = lane >> 4;
    const int K = g.K, nt = K / BK, lda = g.lda ? g.lda : g.K;
    unsigned voffA[2], voffB[2];
#pragma unroll
    for (int i = 0; i < 2; ++i) { int R, C; stage_rc(tid * 16 + i * 8192, R, C); const int Rb = Epi::PERM ? ((R & ~31) + perm32(R & 31)) : R;
        voffA[i] = (unsigned)(R * lda + C) * 2u; voffB[i] = (unsigned)(Rb * K + C) * 2u; }
    const size_t kstep = (size_t)(BK * 2);
    const size_t hstep = (size_t)HALF * K * 2, hstepA = (size_t)HALF * lda * 2, tstepA = 2 * hstepA;
    const size_t tstep = 2 * hstep;
    const unsigned ldsw = (unsigned)wid * 1024u;
    const int aoff = lds_byte(wr * 64 + fr, fq * 8), boff = lds_byte(wc * 32 + fr, fq * 8);
#define PG8_SA(b, h) (((b) * 2 + (h)) * HTB)
#define PG8_SB(b, h) ((4 + (b) * 2 + (h)) * HTB)
#define PG8_STAGE(bufoff, gbase, voff) do { _Pragma("unroll") for (int _i = 0; _i < 2; ++_i) \
        __builtin_amdgcn_global_load_lds((const unsigned*)((const char*)(gbase) + (voff)[_i]), (PG8_LAS unsigned*)(lds + (bufoff) + ldsw + _i * 8192), 16, 0, 0); } while (0)
#define PG8_LDA(dst, b, h) do { _Pragma("unroll") for (int m = 0; m < 4; ++m) _Pragma("unroll") for (int k = 0; k < 2; ++k) dst[m][k] = *(const PG8_LAS bf16x8*)(lds + PG8_SA(b, h) + aoff + m * 2048 + k * 1024); } while (0)
#define PG8_LDB(dst, b, h) do { _Pragma("unroll") for (int n = 0; n < 2; ++n) _Pragma("unroll") for (int k = 0; k < 2; ++k) dst[n][k] = *(const PG8_LAS bf16x8*)(lds + PG8_SB(b, h) + boff + n * 2048 + k * 1024); } while (0)
#define PG8_MMA(ai, bj, At, Bt) do { __builtin_amdgcn_s_setprio(1); _Pragma("unroll") for (int m = 0; m < 4; ++m) _Pragma("unroll") for (int n = 0; n < 2; ++n) _Pragma("unroll") for (int k = 0; k < 2; ++k) \
        acc[ai][bj][m][n] = __builtin_amdgcn_mfma_f32_16x16x32_bf16(Bt[n][k], At[m][k], acc[ai][bj][m][n], 0, 0, 0); __builtin_amdgcn_s_setprio(0); } while (0)
#define PG8_WAIT_V(n) asm volatile("s_waitcnt vmcnt(" #n ")" ::: "memory")
#define PG8_WAIT_L(n) asm volatile("s_waitcnt lgkmcnt(" #n ")" ::: "memory")
#define PG8_BAR __builtin_amdgcn_s_barrier()
#define PG8_SCHED __builtin_amdgcn_sched_barrier(0)
    Unit cur, nxt; int ui = 0;
    if (!S.next(0, cur)) return;
    f32x4 acc[2][2][4][2];
#pragma unroll
    for (int a = 0; a < 2; ++a)
#pragma unroll
        for (int b = 0; b < 2; ++b)
#pragma unroll
            for (int m = 0; m < 4; ++m)
#pragma unroll
                for (int n = 0; n < 2; ++n) acc[a][b][m][n] = (f32x4){0.f, 0.f, 0.f, 0.f};
    bf16x8 At[4][2], B0[2][2], B1[2][2];
    const char* cA = (const char*)g.A + (size_t)cur.gb * g.strideA + (size_t)cur.pm * tstepA; const char* cB = (const char*)g.Bt + (size_t)cur.gb * g.strideB + (size_t)cur.pn * tstep;
    S.a_ready(cur);
    if constexpr (SP2) {
        PG8_STAGE(PG8_SB(0, 0), cB, voffB); PG8_STAGE(PG8_SB(0, 1), cB + hstep, voffB); PG8_STAGE(PG8_SA(0, 0), cA, voffA); PG8_STAGE(PG8_SA(0, 1), cA + hstepA, voffA);
        if (wr == 1) PG8_BAR;
        PG8_WAIT_V(2); PG8_BAR;
        PG8_STAGE(PG8_SB(1, 0), cB + kstep, voffB); PG8_STAGE(PG8_SA(1, 0), cA + kstep, voffA); PG8_STAGE(PG8_SB(1, 1), cB + hstep + kstep, voffB);
        PG8_WAIT_V(6); PG8_BAR;
    } else {
        PG8_STAGE(PG8_SB(0, 0), cB, voffB); PG8_STAGE(PG8_SA(0, 0), cA, voffA); PG8_STAGE(PG8_SB(0, 1), cB + hstep, voffB); PG8_STAGE(PG8_SA(0, 1), cA + hstepA, voffA);
        if (wr == 1) PG8_BAR;
        PG8_WAIT_V(4); PG8_BAR;
        PG8_STAGE(PG8_SB(1, 0), cB + kstep, voffB); PG8_STAGE(PG8_SA(1, 0), cA + kstep, voffA); PG8_STAGE(PG8_SB(1, 1), cB + hstep + kstep, voffB);
        PG8_WAIT_V(6); PG8_BAR;
    }
    for (;;) {
        const bool has_next = S.next(ui + 1, nxt);
        const char* nA = has_next ? (const char*)g.A + (size_t)nxt.gb * g.strideA + (size_t)nxt.pm * tstepA : cA; const char* nB = has_next ? (const char*)g.Bt + (size_t)nxt.gb * g.strideB + (size_t)nxt.pn * tstep : cB;
        for (int t = 0; t < nt; t += 2) {
            const bool last = (t == nt - 2);
            const char* a1 = cA + (size_t)(t + 1) * kstep;
            const char* a2 = last ? nA : cA + (size_t)(t + 2) * kstep; const char* b2 = last ? nB : cB + (size_t)(t + 2) * kstep;
            const char* a3 = a2 + kstep; const char* b3 = b2 + kstep;
            if (last && has_next) S.a_ready(nxt);
            if constexpr (SP2) {
            PG8_LDB(B0, 0, 0); PG8_LDB(B1, 0, 1); PG8_SCHED; PG8_LDA(At, 0, 0); PG8_STAGE(PG8_SA(1, 1), a1 + hstepA, voffA);
            PG8_WAIT_V(8); PG8_WAIT_L(0); PG8_BAR; PG8_MMA(0, 0, At, B0); PG8_MMA(0, 1, At, B1); PG8_BAR; PG8_SCHED;
            PG8_LDA(At, 0, 1); PG8_STAGE(PG8_SB(0, 0), b2, voffB); PG8_STAGE(PG8_SB(0, 1), b2 + hstep, voffB); PG8_STAGE(PG8_SA(0, 0), a2, voffA);
            PG8_WAIT_V(8); PG8_WAIT_L(0); PG8_BAR; PG8_MMA(1, 0, At, B0); PG8_MMA(1, 1, At, B1); PG8_BAR; PG8_SCHED;
            PG8_LDB(B0, 1, 0); PG8_LDB(B1, 1, 1); PG8_SCHED; PG8_LDA(At, 1, 0); PG8_STAGE(PG8_SA(0, 1), a2 + hstepA, voffA);
            PG8_WAIT_V(8); PG8_WAIT_L(0); PG8_BAR; PG8_MMA(0, 0, At, B0); PG8_MMA(0, 1, At, B1); PG8_BAR; PG8_SCHED;
            PG8_LDA(At, 1, 1); PG8_STAGE(PG8_SB(1, 0), b3, voffB); PG8_STAGE(PG8_SB(1, 1), b3 + hstep, voffB); PG8_STAGE(PG8_SA(1, 0), a3, voffA);
            PG8_WAIT_V(8); PG8_WAIT_L(0); PG8_BAR; PG8_MMA(1, 0, At, B0); PG8_MMA(1, 1, At, B1); PG8_BAR; PG8_SCHED;
            } else {
            PG8_LDB(B0, 0, 0); PG8_SCHED; PG8_LDA(At, 0, 0); PG8_STAGE(PG8_SA(1, 1), a1 + hstepA, voffA);
            PG8_WAIT_L(8); PG8_BAR; PG8_WAIT_L(0); PG8_MMA(0, 0, At, B0); PG8_BAR; PG8_SCHED;
            PG8_LDB(B1, 0, 1); PG8_STAGE(PG8_SB(0, 0), b2, voffB);
            PG8_BAR; PG8_WAIT_L(0); PG8_MMA(0, 1, At, B1); PG8_BAR;
            PG8_LDA(At, 0, 1); PG8_STAGE(PG8_SA(0, 0), a2, voffA);
            PG8_BAR; PG8_WAIT_L(0); PG8_MMA(1, 0, At, B0); PG8_BAR; PG8_SCHED;
            PG8_STAGE(PG8_SB(0, 1), b2 + hstep, voffB);
            PG8_WAIT_V(6); PG8_BAR; PG8_MMA(1, 1, At, B1); PG8_BAR;
            PG8_LDB(B0, 1, 0); PG8_SCHED; PG8_LDA(At, 1, 0); PG8_STAGE(PG8_SA(0, 1), a2 + hstepA, voffA);
            PG8_WAIT_L(8); PG8_BAR; PG8_WAIT_L(0); PG8_MMA(0, 0, At, B0); PG8_BAR; PG8_SCHED;
            PG8_LDB(B1, 1, 1); PG8_STAGE(PG8_SB(1, 0), b3, voffB);
            PG8_BAR; PG8_WAIT_L(0); PG8_MMA(0, 1, At, B1); PG8_BAR;
            PG8_LDA(At, 1, 1); PG8_STAGE(PG8_SA(1, 0), a3, voffA);
            PG8_BAR; PG8_WAIT_L(0); PG8_MMA(1, 0, At, B0); PG8_BAR; PG8_SCHED;
            PG8_STAGE(PG8_SB(1, 1), b3 + hstep, voffB);
            PG8_WAIT_V(6); PG8_BAR; PG8_MMA(1, 1, At, B1); PG8_BAR;
            }
        }
        if constexpr (ALIGN_EPI) { if (wr == 0) PG8_BAR; }
        if constexpr (!Epi::AFTER_DRAIN) { E(acc, cur, wr, wc, fr, fq); S.done(cur); }
        if (!has_next) break;
#pragma unroll
        for (int a = 0; a < 2; ++a)
#pragma unroll
            for (int b = 0; b < 2; ++b)
#pragma unroll
                for (int m = 0; m < 4; ++m)
#pragma unroll
                    for (int n = 0; n < 2; ++n) acc[a][b][m][n] = (f32x4){0.f, 0.f, 0.f, 0.f};
        cur = nxt; cA = nA; cB = nB; ++ui;
        if constexpr (ALIGN_EPI) { if (wr == 1) PG8_BAR; }
    }
    PG8_WAIT_V(0);
    if constexpr (!ALIGN_EPI) { if (wr == 0) PG8_BAR; }
    PG8_BAR;
    if constexpr (Epi::AFTER_DRAIN) { E.fused(acc, cur, wr, wc, fr, fq, lds, wid, lane); S.done(cur); }
#undef PG8_SA
#undef PG8_SB
#undef PG8_STAGE
#undef PG8_LDA
#undef PG8_LDB
#undef PG8_MMA
#undef PG8_WAIT_V
#undef PG8_WAIT_L
#undef PG8_BAR
#undef PG8_SCHED
}
}

namespace attn {
using bf16 = __hip_bfloat16;
constexpr int   D = 128, NW = 8, QBLK = 32, KVBLK = 64;
constexpr float SCALE = 0.088388347648318440f;
constexpr float THR = 8.f;
constexpr int SDEPTH = 2;
constexpr int LDQ = 1536, LDK = 1536, LDO = 1024;
constexpr size_t SHM_V = KVBLK * D * 2, SHM_K = KVBLK * D * 2, SHM_ATTN = 2 * SHM_V + 2 * SHM_K + NW * 64 * 4;
__device__ __forceinline__ unsigned short f2bf_rne(float f) { unsigned u = __builtin_bit_cast(unsigned, f); return (unsigned short)((u + 0x7fffu + ((u >> 16) & 1u)) >> 16); }
using bf16x8 = __attribute__((ext_vector_type(8))) short;
using s16x4  = __attribute__((ext_vector_type(4))) short;
using f32x16 = __attribute__((ext_vector_type(16))) float;
using f32x8  = __attribute__((ext_vector_type(8))) float;
using u32x4  = __attribute__((ext_vector_type(4))) unsigned;
#define KSWZ(row, colB) ((row) * 256 + ((colB) ^ (((row) & 7) << 4)))
#define SBAR() __builtin_amdgcn_sched_barrier(0)
__device__ __forceinline__ int crow(int r, int hi) { return (r & 3) + 8 * (r >> 2) + 4 * hi; }
__device__ __forceinline__ unsigned cvtpk(float lo, float hi) {
  unsigned r; asm volatile("v_cvt_pk_bf16_f32 %0, %1, %2" : "=v"(r) : "v"(lo), "v"(hi)); return r;
}
template <typename TIn> struct Stage;
template <> struct Stage<bf16>  { using T = bf16x8;
  __device__ static __forceinline__ T ld8(const bf16* p) { return *reinterpret_cast<const bf16x8*>(p); }
  __device__ static __forceinline__ bf16x8 tobf(T x) { return x; } };
template <> struct Stage<float> { using T = f32x8;
  __device__ static __forceinline__ T ld8(const float* p) { return *reinterpret_cast<const f32x8*>(p); }
  __device__ static __forceinline__ bf16x8 tobf(T x) {
    u32x4 w = {cvtpk(x[0], x[1]), cvtpk(x[2], x[3]), cvtpk(x[4], x[5]), cvtpk(x[6], x[7])}; return *reinterpret_cast<bf16x8*>(&w); } };

__device__ __forceinline__ void partialSM(f32x16& p0, f32x16& p1, float& m_reg, float& mn, float& alpha) {
  constexpr float C = SCALE * 1.4426950408889634f;
  float pmax = p0[0]; for (int r = 1; r < 16; ++r) pmax = fmaxf(pmax, p0[r]); for (int r = 0; r < 16; ++r) pmax = fmaxf(pmax, p1[r]);
  { auto rr = __builtin_amdgcn_permlane32_swap(__float_as_uint(pmax), __float_as_uint(pmax), false, false);
    pmax = fmaxf(__uint_as_float(rr[0]), __uint_as_float(rr[1])); }
  if (__builtin_expect(__all(pmax - m_reg <= THR / SCALE), 1)) { mn = m_reg; alpha = 1.f; }
  else { mn = fmaxf(m_reg, pmax); alpha = __builtin_amdgcn_exp2f((m_reg - mn) * C); m_reg = mn; }
  float mnC = -mn * C;
  for (int r = 0; r < 16; ++r) p0[r] = fmaf(p0[r], C, mnC); for (int r = 0; r < 16; ++r) p1[r] = fmaf(p1[r], C, mnC);
  for (int r = 0; r < 16; ++r) p0[r] = __builtin_amdgcn_exp2f(p0[r]);
}
__device__ __forceinline__ void finishSM(f32x16& p0, f32x16& p1, float alpha, float& l_reg, bf16x8& pa0, bf16x8& pa1, bf16x8& pa2, bf16x8& pa3) {
  for (int r = 0; r < 16; ++r) p1[r] = __builtin_amdgcn_exp2f(p1[r]);
  float ps = 0; for (int r = 0; r < 16; ++r) ps += p0[r]; for (int r = 0; r < 16; ++r) ps += p1[r];
  { auto rr = __builtin_amdgcn_permlane32_swap(__float_as_uint(ps), __float_as_uint(ps), false, false);
    ps = __uint_as_float(rr[0]) + __uint_as_float(rr[1]); }
  l_reg = l_reg * alpha + ps;
#define PK4(P, BASE, OUT) do { unsigned a0 = cvtpk(P[BASE + 0], P[BASE + 1]), a1 = cvtpk(P[BASE + 2], P[BASE + 3]);   \
    unsigned b0 = cvtpk(P[BASE + 4], P[BASE + 5]), b1 = cvtpk(P[BASE + 6], P[BASE + 7]);                              \
    auto r0 = __builtin_amdgcn_permlane32_swap(a0, b0, false, false); auto r1 = __builtin_amdgcn_permlane32_swap(a1, b1, false, false); \
    u32x4 w = {r0[0], r1[0], r0[1], r1[1]}; OUT = *reinterpret_cast<bf16x8*>(&w); } while (0)
  PK4(p0, 0, pa0); PK4(p0, 8, pa1); PK4(p1, 0, pa2); PK4(p1, 8, pa3);
#undef PK4
}
__device__ __forceinline__ void qkt(f32x16& p0, f32x16& p1, const bf16* Ks, const bf16x8* qr, int r32, int hi) {
  p0 = f32x16{}; p1 = f32x16{};
  for (int d0 = 0; d0 < 8; ++d0) { int cb = (d0 * 16 + hi * 8) * 2;
    bf16x8 b0 = *reinterpret_cast<const bf16x8*>((const char*)Ks + KSWZ(r32, cb));
    bf16x8 b1 = *reinterpret_cast<const bf16x8*>((const char*)Ks + KSWZ(32 + r32, cb));
    p0 = __builtin_amdgcn_mfma_f32_32x32x16_bf16(b0, qr[d0], p0, 0, 0, 0);
    p1 = __builtin_amdgcn_mfma_f32_32x32x16_bf16(b1, qr[d0], p1, 0, 0, 0); }
}
__device__ __forceinline__ int v_st(int k, int c) { const int kk = (k & ~0xC) | ((k & 4) << 1) | ((k & 8) >> 1); return ((kk >> 3) * 4 + (c >> 5)) * 512 + ((kk & 7) * 32 + (c & 31)) * 2; }
__device__ __forceinline__ int v_rd_base(int lane) { return ((lane & 3) << 3) | (((lane >> 2) & 3) << 6) | (((lane >> 4) & 1) << 5) | (((lane >> 5) & 1) << 8); }
constexpr int v_rd_off(int d0, int ks, int half) { return d0 * 512 + ks * 4096 + half * 2048; }
template <int OFF> __device__ __forceinline__ s16x4 tr_read(int vb) {
  s16x4 r; asm volatile("ds_read_b64_tr_b16 %0, %1 offset:%2" : "=&v"(r) : "v"(vb), "i"(OFF) : "memory"); return r;
}
template <int D0> __device__ __forceinline__ void pv_one(f32x16& od, int vb, bf16x8 pa0, bf16x8 pa1, bf16x8 pa2, bf16x8 pa3) {
  const s16x4 l0 = tr_read<v_rd_off(D0, 0, 0)>(vb), h0 = tr_read<v_rd_off(D0, 0, 1)>(vb), l1 = tr_read<v_rd_off(D0, 1, 0)>(vb), h1 = tr_read<v_rd_off(D0, 1, 1)>(vb);
  const s16x4 l2 = tr_read<v_rd_off(D0, 2, 0)>(vb), h2 = tr_read<v_rd_off(D0, 2, 1)>(vb), l3 = tr_read<v_rd_off(D0, 3, 0)>(vb), h3 = tr_read<v_rd_off(D0, 3, 1)>(vb);
  asm volatile("s_waitcnt lgkmcnt(0)" ::: "memory"); SBAR();
#define PK(L, H) (bf16x8){L[0], L[1], L[2], L[3], H[0], H[1], H[2], H[3]}
  od = __builtin_amdgcn_mfma_f32_32x32x16_bf16(pa0, PK(l0, h0), od, 0, 0, 0);
  od = __builtin_amdgcn_mfma_f32_32x32x16_bf16(pa1, PK(l1, h1), od, 0, 0, 0);
  od = __builtin_amdgcn_mfma_f32_32x32x16_bf16(pa2, PK(l2, h2), od, 0, 0, 0);
  od = __builtin_amdgcn_mfma_f32_32x32x16_bf16(pa3, PK(l3, h3), od, 0, 0, 0);
#undef PK
}
__device__ __forceinline__ void pv_d0(f32x16* o, int vb, bf16x8 pa0, bf16x8 pa1, bf16x8 pa2, bf16x8 pa3) {
  pv_one<0>(o[0], vb, pa0, pa1, pa2, pa3); pv_one<1>(o[1], vb, pa0, pa1, pa2, pa3); pv_one<2>(o[2], vb, pa0, pa1, pa2, pa3); pv_one<3>(o[3], vb, pa0, pa1, pa2, pa3);
}

template <typename TQ>
__device__ __forceinline__ void attn_dense_body(const TQ* __restrict__ Qb, const bf16* __restrict__ Kh, const bf16* __restrict__ Vh,
                                                unsigned short* __restrict__ Ob, int seq, char* lds, const int wave_s) {
  using St = Stage<bf16>; using SQ = Stage<TQ>;
  const int lane = lane_id_asm(), wid = wave_s, tid = wave_s * 64 + lane, r32 = lane & 31, hi = lane >> 5;
  bf16* V_lds = (bf16*)lds; bf16* K_lds = (bf16*)(lds + 2 * SHM_V);
  float* ws = (float*)(lds + 2 * SHM_V + 2 * SHM_K) + wid * 64; float* li_l = ws; float* al_l = ws + 32;
  float m_reg = -1e30f, l_reg = 0; f32x16 o[4] = {}; bf16x8 qr[8];
  const TQ* Qw = Qb + (long)(wid * QBLK + r32) * LDQ + hi * 8;
#pragma unroll
  for (int d0 = 0; d0 < 8; ++d0) qr[d0] = SQ::tobf(SQ::ld8(Qw + d0 * 16));
  const int sr = tid >> 4, sc = (tid & 15) * 8, vst0 = v_st(sr, sc), vst1 = v_st(32 + sr, sc);
  const int vb0 = (int)(uintptr_t)V_lds + v_rd_base(lane);
  struct { typename St::T vs0, vs1, ks0, ks1; } sr_[SDEPTH];
#define SLOAD(i, k0) do { sr_[i].vs0 = St::ld8(&Vh[(long)((k0) + sr) * LDK + sc]); sr_[i].vs1 = St::ld8(&Vh[(long)((k0) + 32 + sr) * LDK + sc]); \
    sr_[i].ks0 = St::ld8(&Kh[(long)((k0) + sr) * LDK + sc]); sr_[i].ks1 = St::ld8(&Kh[(long)((k0) + 32 + sr) * LDK + sc]); } while (0)
#define SWRITE(b, i) do { *(bf16x8*)((char*)V_lds + (b) * SHM_V + vst0) = St::tobf(sr_[i].vs0);          \
    *(bf16x8*)((char*)V_lds + (b) * SHM_V + vst1) = St::tobf(sr_[i].vs1); int kc = sc * 2;               \
    *(bf16x8*)((char*)K_lds + (b) * SHM_K + KSWZ(sr, kc)) = St::tobf(sr_[i].ks0);                       \
    *(bf16x8*)((char*)K_lds + (b) * SHM_K + KSWZ(32 + sr, kc)) = St::tobf(sr_[i].ks1); } while (0)
#define SWAIT() do { if constexpr (SDEPTH == 2) asm volatile("s_waitcnt vmcnt(4)" ::: "memory"); else asm volatile("s_waitcnt vmcnt(0)" ::: "memory"); } while (0)
#define RESC(a) do { if (__any((a) < 1.f)) { if (hi == 0) al_l[r32] = (a); asm volatile("s_waitcnt lgkmcnt(0)" ::: "memory"); \
    for (int d = 0; d < 4; ++d) for (int r = 0; r < 16; ++r) o[d][r] *= al_l[crow(r, hi)]; } } while (0)
  f32x16 pA0, pA1, pB0, pB1; float mnA, mnB, alA, alB; bf16x8 pa0, pa1, pa2, pa3; const int NT = seq / KVBLK;
  constexpr int SE = 0, SO = SDEPTH - 1;
  SLOAD(SE, 0); asm volatile("s_waitcnt vmcnt(0)" ::: "memory"); SWRITE(0, SE); __syncthreads();
  qkt(pA0, pA1, K_lds, qr, r32, hi); partialSM(pA0, pA1, m_reg, mnA, alA);
  SLOAD(SO, KVBLK); if constexpr (SDEPTH == 2) { if (2 < NT) SLOAD(SE, 2 * KVBLK); }
  SWAIT(); SWRITE(1, SO); __syncthreads();
  for (int j = 1; j + 1 < NT; j += 2) {
    SBAR(); qkt(pB0, pB1, (bf16*)((char*)K_lds + SHM_K), qr, r32, hi);
    finishSM(pA0, pA1, alA, l_reg, pa0, pa1, pa2, pa3); SBAR();
    SLOAD(SO, (j + SDEPTH) * KVBLK); SBAR();
    pv_d0(o, vb0, pa0, pa1, pa2, pa3); partialSM(pB0, pB1, m_reg, mnB, alB);
    __syncthreads(); SWAIT(); SWRITE(0, SE);
    RESC(alB); __syncthreads();
    SBAR(); qkt(pA0, pA1, K_lds, qr, r32, hi);
    finishSM(pB0, pB1, alB, l_reg, pa0, pa1, pa2, pa3); SBAR();
    if (SDEPTH == 1 || j + 3 < NT) SLOAD(SE, (j + 1 + SDEPTH) * KVBLK); SBAR();
    pv_d0(o, vb0 + (int)SHM_V, pa0, pa1, pa2, pa3); partialSM(pA0, pA1, m_reg, mnA, alA);
    __syncthreads(); SWAIT(); SWRITE(1, SO);
    RESC(alA); __syncthreads();
  }
  SBAR(); qkt(pB0, pB1, (bf16*)((char*)K_lds + SHM_K), qr, r32, hi);
  finishSM(pA0, pA1, alA, l_reg, pa0, pa1, pa2, pa3); SBAR();
  pv_d0(o, vb0, pa0, pa1, pa2, pa3); partialSM(pB0, pB1, m_reg, mnB, alB);
  __syncthreads(); RESC(alB);
  finishSM(pB0, pB1, alB, l_reg, pa0, pa1, pa2, pa3); SBAR();
  pv_d0(o, vb0 + (int)SHM_V, pa0, pa1, pa2, pa3);
  if (hi == 0) li_l[r32] = l_reg; asm volatile("s_waitcnt lgkmcnt(0)" ::: "memory");
  float rli[16];
#pragma unroll
  for (int r = 0; r < 16; ++r) rli[r] = __builtin_amdgcn_rcpf(li_l[crow(r, hi)]);
  unsigned short* Ow = Ob + (long)(wid * QBLK) * LDO;
#pragma unroll
  for (int r = 0; r < 16; ++r) { int orow = crow(r, hi);
    for (int d0 = 0; d0 < 4; ++d0) Ow[(long)orow * LDO + d0 * 32 + r32] = f2bf_rne(o[d0][r] * rli[r]); }
#undef SLOAD
#undef SWRITE
#undef SWAIT
#undef RESC
}
}

#define LAS __attribute__((address_space(3)))
typedef unsigned short bf16_t;
typedef unsigned v4u __attribute__((ext_vector_type(4)));
typedef float f32x4 __attribute__((ext_vector_type(4)));
typedef float f32x2 __attribute__((ext_vector_type(2)));
struct Args { const float* in[24]; float* out; unsigned char* ws; };
#define LDS_WAIT() asm volatile("s_waitcnt lgkmcnt(0)" ::: "memory")
__device__ __forceinline__ unsigned f2bf(float f) { unsigned u = __builtin_bit_cast(unsigned, f); return (u + 0x7fffu + ((u >> 16) & 1u)) >> 16; }
__device__ __forceinline__ unsigned pk2(float lo, float hi) { return f2bf(lo) | (f2bf(hi) << 16); }
__device__ __forceinline__ float wave_sum(float v, int lane) {
#pragma unroll
    for (int o = 1; o < 64; o <<= 1) v += __builtin_bit_cast(float, __builtin_amdgcn_ds_bpermute((lane ^ o) << 2, __builtin_bit_cast(int, v)));
    return v;
}
__device__ __forceinline__ void sincos_rev(float ang, float& s, float& c) {
    float rev = ang * 0.15915494309189535f; rev = rev - floorf(rev); s = __builtin_amdgcn_sinf(rev); c = __builtin_amdgcn_cosf(rev);
}

__device__ __forceinline__ void transpose_item(const float* __restrict__ W, int K, int N, bf16_t* __restrict__ WT, int mode, int halfw, LAS float* scr, int item, int lane) {
    const int nblk = N / 32, kb = item / nblk, nb = item % nblk, k0 = 64 * kb, n0 = 32 * nb;
    const int nn = n0 + (lane & 31);
    int sc = nn;
    if (mode == 1) { if (nn < 1280) { const int s = nn & 127; sc = (nn & ~127) + ((s >> 6) & 1) * 64 + ((s >> 5) & 1) * 16 + ((s >> 3) & 3) * 4 + (s & 3) + ((s >> 2) & 1) * 32; } }
    else if (mode == 2) sc = ((nn >> 7) & 1) * halfw + (nn >> 8) * 128 + (nn & 127);
    float tv[32];
#pragma unroll
    for (int i = 0; i < 32; ++i) tv[i] = W[(size_t)(k0 + 2 * i + (lane >> 5)) * N + sc];
#pragma unroll
    for (int i = 0; i < 32; ++i) scr[(2 * i + (lane >> 5)) * 33 + (lane & 31)] = tv[i];
    LDS_WAIT(); asm volatile("" ::: "memory");
    const int c = lane & 7;
#pragma unroll
    for (int j = 0; j < 4; ++j) { const int n = (lane >> 3) + 8 * j; const LAS float* s = scr + (8 * c) * 33 + n;
        v4u o; o.x = pk2(s[0 * 33], s[1 * 33]); o.y = pk2(s[2 * 33], s[3 * 33]); o.z = pk2(s[4 * 33], s[5 * 33]); o.w = pk2(s[6 * 33], s[7 * 33]);
        *(v4u*)(WT + (size_t)(n0 + n) * K + k0 + 8 * c) = o; }
    LDS_WAIT(); asm volatile("" ::: "memory");
}

__device__ __forceinline__ void ssm_build(const Args& a, int j, int g, LAS unsigned char* lds, unsigned char* ws) {
    const int tid = threadIdx.x;
    LAS f32x2* lam = (LAS f32x2*)lds;
    LAS f32x2* bbar = lam + 2 * 33 * 65;
    LAS f32x2* cc = bbar + 2 * 64 * 16;
    LAS float* Kt = (LAS float*)(cc + 2 * 16 * 65);
    LAS f32x2* fco = (LAS f32x2*)(Kt + 2 * 32 * 256);
    const float* a_re = a.in[12]; const float* a_im = a.in[13]; const float* log_dt = a.in[14];
    const float* b_re = a.in[15]; const float* b_im = a.in[16]; const float* c_re = a.in[17]; const float* c_im = a.in[18]; const float* dd = a.in[19];
    if (tid < 128) {
        const int dir = tid >> 6, p = tid & 63, gi = (j * 2 + dir) * 64 + g, idx = gi * 64 + p;
        const float are = a_re[idx], aim = a_im[idx], dt = expf(log_dt[gi]);
        for (int tau = 0; tau <= 32; ++tau) { const float mag = expf((float)tau * dt * are); float s, c; sincos_rev((float)tau * dt * aim, s, c); lam[(dir * 33 + tau) * 65 + p] = (f32x2){mag * c, mag * s}; }
        const float mag = expf(dt * are); float s1, c1, sh, ch; sincos_rev(dt * aim, s1, c1); sincos_rev(0.5f * dt * aim, sh, ch);
        const float nr = expm1f(dt * are) - 2.0f * mag * sh * sh, ai1 = mag * s1, den = are * are + aim * aim;
        fco[dir * 64 + p] = (f32x2){(nr * are + ai1 * aim) / den, (ai1 * are - nr * aim) / den};
    }
    __syncthreads();
    for (int e = tid; e < 2048; e += 512) {
        { const int dir = e >> 10, p = (e >> 4) & 63, h = e & 15; const size_t idx = ((size_t)((j * 2 + dir) * 64 + g) * 64 + p) * 16 + h;
          const float br = b_re[idx], bi = b_im[idx]; const f32x2 f = fco[dir * 64 + p]; bbar[e] = (f32x2){f.x * br - f.y * bi, f.x * bi + f.y * br}; }
        { const int dir = e >> 10, h = (e >> 6) & 15, p = e & 63; const size_t idx = ((size_t)((j * 2 + dir) * 64 + g) * 16 + h) * 64 + p; cc[(dir * 16 + h) * 65 + p] = (f32x2){c_re[idx], c_im[idx]}; }
    }
    __syncthreads();
    {
        const int combo = tid >> 3, dir = combo >> 5, tau = combo & 31, h0 = (tid & 7) * 2; float a0[16], a1[16];
#pragma unroll
        for (int q = 0; q < 16; ++q) { a0[q] = 0.f; a1[q] = 0.f; }
        for (int p = 0; p < 64; ++p) { const f32x2 Lv = lam[(dir * 33 + tau) * 65 + p], C0 = cc[(dir * 16 + h0) * 65 + p], C1 = cc[(dir * 16 + h0 + 1) * 65 + p];
#pragma unroll
            for (int q = 0; q < 16; ++q) { const f32x2 B = bbar[(dir * 64 + p) * 16 + q]; const float gx = Lv.x * B.x - Lv.y * B.y, gy = Lv.x * B.y + Lv.y * B.x;
                a0[q] += C0.x * gx - C0.y * gy; a1[q] += C1.x * gx - C1.y * gy; } }
#pragma unroll
        for (int q = 0; q < 16; ++q) { Kt[((dir * 32 + tau) * 16 + h0) * 16 + q] = a0[q]; Kt[((dir * 32 + tau) * 16 + h0 + 1) * 16 + q] = a1[q]; }
    }
    __syncthreads();
    bf16_t* base = (bf16_t*)(ws + WS_SSM + (size_t)(j * 64 + g) * MiB);
    for (int it = tid; it < 32768; it += 512) {
        const int n = it >> 6, kb = it & 63, t = n >> 4, h = n & 15, s = kb >> 1, hp0 = (kb & 1) * 8; float v[8];
#pragma unroll
        for (int e = 0; e < 8; ++e) { const int hp = hp0 + e; float x = 0.f;
            if (s <= t) x += Kt[((0 * 32 + (t - s)) * 16 + h) * 16 + hp];
            if (s >= t) x += Kt[((1 * 32 + (s - t)) * 16 + h) * 16 + hp];
            if (s == t && h == hp) x += dd[j * 1024 + g * 16 + h];
            v[e] = x; }
        v4u o; o.x = pk2(v[0], v[1]); o.y = pk2(v[2], v[3]); o.z = pk2(v[4], v[5]); o.w = pk2(v[6], v[7]);
        *(v4u*)(base + (size_t)n * 768 + kb * 8) = o;
    }
    for (int it = tid; it < 16384; it += 512) {
        const int n = it >> 6, kb = it & 63, dir = n >> 7, ri = (n >> 6) & 1, p = n & 63, s = kb >> 1, hp0 = (kb & 1) * 8, ex = dir ? s : 31 - s; float v[8];
        const f32x2 L = lam[(dir * 33 + ex) * 65 + p];
#pragma unroll
        for (int e = 0; e < 8; ++e) { const f32x2 B = bbar[(dir * 64 + p) * 16 + hp0 + e]; v[e] = ri ? (L.x * B.y + L.y * B.x) : (L.x * B.x - L.y * B.y); }
        v4u o; o.x = pk2(v[0], v[1]); o.y = pk2(v[2], v[3]); o.z = pk2(v[4], v[5]); o.w = pk2(v[6], v[7]);
        *(v4u*)(base + (size_t)512 * 768 + (size_t)n * 512 + kb * 8) = o;
    }
    bf16_t* wc = base + 512;
    for (int it = tid; it < 16384; it += 512) {
        const int n = it >> 5, k0 = (it & 31) * 8, dir = k0 >> 7, ri = (k0 >> 6) & 1, p0 = k0 & 63, t = n >> 4, h = n & 15, ex = dir ? 32 - t : t + 1; float v[8];
#pragma unroll
        for (int e = 0; e < 8; ++e) { const f32x2 L = lam[(dir * 33 + ex) * 65 + p0 + e], C = cc[(dir * 16 + h) * 65 + p0 + e]; v[e] = ri ? -(C.x * L.y + C.y * L.x) : (C.x * L.x - C.y * L.y); }
        v4u o; o.x = pk2(v[0], v[1]); o.y = pk2(v[2], v[3]); o.z = pk2(v[4], v[5]); o.w = pk2(v[6], v[7]);
        *(v4u*)(wc + (size_t)n * 768 + k0) = o;
    }
    if (tid < 128) { const int dir = tid >> 6, p = tid & 63; ((f32x2*)(ws + WS_LAM))[((j * 64 + g) * 2 + dir) * 64 + p] = lam[(dir * 33 + 32) * 65 + p]; }
    __syncthreads();
}

__device__ __forceinline__ void init_rows(const Args& a, const float* gain, const float* mod0, bf16_t* HA, bf16_t* XB, pg8::rss_t* rss0, int gw, int NGW) {
    const int lane = lane_id_asm(), fr = lane & 15, fq = lane >> 4;
    for (int gi = gw; gi < TT / 16; gi += NGW) {
        const int row = gi * 16 + fr, pm = gi >> 4, am = ((gi >> 3) & 1) * 4 + (gi & 3), wr = (gi >> 2) & 1;
        const float* xr = row < LP ? a.in[0] + (size_t)row * DM : a.in[1] + (size_t)(row - LP) * DM;
        const int b = row < LP ? 0 : 1 + (row - LP) / LS;
        const float* scp = mod0 + (size_t)b * 6144 + 1024;
        float ss = 0.f;
#pragma unroll 4
        for (int it = 0; it < 32; ++it) { const int pnq = it >> 2, wc = it & 3, c0 = pnq * 128 + wc * 32 + fq * 8;
            const f32x4 x0 = __builtin_nontemporal_load((const f32x4*)(xr + c0)), x1 = __builtin_nontemporal_load((const f32x4*)(xr + c0 + 4));
            const f32x4 g0 = *(const f32x4*)(gain + c0), g1 = *(const f32x4*)(gain + c0 + 4), s0 = *(const f32x4*)(scp + c0), s1 = *(const f32x4*)(scp + c0 + 4);
            ss += (x0.x * x0.x + x0.y * x0.y) + (x0.z * x0.z + x0.w * x0.w) + (x1.x * x1.x + x1.y * x1.y) + (x1.z * x1.z + x1.w * x1.w);
            *(pg8::u32x4*)(XB + ((size_t)((((pm * 8 + pnq) * 2 + wr) * 4 + wc) * 8 + am) * 64 + lane) * 8) = pg8::f32_to_h8(x0, x1);
            *(pg8::u32x4*)(HA + (size_t)row * DM + c0) = pg8::f32_to_bf8(x0 * g0 * (s0 + 1.0f), x1 * g1 * (s1 + 1.0f)); }
        ss += pg8::bperm_f(lane ^ 16, ss); ss += pg8::bperm_f(lane ^ 32, ss);
        if (fq == 0) rss0[row] = pg8::rss_fix(ss);
    }
}
__device__ __forceinline__ void bias_rows(const bf16_t* WT, int N, const float* modl, int shi, float* bias, int r0, int r1, int lane) {
    f32x4 sh[NB][4];
#pragma unroll
    for (int b = 0; b < NB; ++b)
#pragma unroll
        for (int q = 0; q < 4; ++q) sh[b][q] = *((const f32x4*)(modl + (size_t)b * 6144 + shi * 1024 + lane * 16) + q);
    v4u w0 = *(const v4u*)(WT + (size_t)r0 * 1024 + lane * 16), w1 = *(const v4u*)(WT + (size_t)r0 * 1024 + lane * 16 + 8);
    for (int it = r0; it < r1; ++it) {
        const int nx = it + 1 < r1 ? it + 1 : it;
        const v4u n0 = *(const v4u*)(WT + (size_t)nx * 1024 + lane * 16), n1 = *(const v4u*)(WT + (size_t)nx * 1024 + lane * 16 + 8);
        float wf[16];
#pragma unroll
        for (int q = 0; q < 4; ++q) { wf[2 * q] = __builtin_bit_cast(float, w0[q] << 16); wf[2 * q + 1] = __builtin_bit_cast(float, w0[q] & 0xffff0000u);
            wf[8 + 2 * q] = __builtin_bit_cast(float, w1[q] << 16); wf[8 + 2 * q + 1] = __builtin_bit_cast(float, w1[q] & 0xffff0000u); }
        float s[NB];
#pragma unroll
        for (int b = 0; b < NB; ++b) { s[b] = 0.f;
#pragma unroll
            for (int q = 0; q < 4; ++q) s[b] += (sh[b][q].x * wf[4 * q] + sh[b][q].y * wf[4 * q + 1]) + (sh[b][q].z * wf[4 * q + 2] + sh[b][q].w * wf[4 * q + 3]); }
#pragma unroll
        for (int o = 1; o < 64; o <<= 1)
#pragma unroll
            for (int b = 0; b < NB; ++b) s[b] += __builtin_bit_cast(float, __builtin_amdgcn_ds_bpermute((lane ^ o) << 2, __builtin_bit_cast(int, s[b])));
        if (lane < NB) { float v = s[0];
#pragma unroll
            for (int b = 1; b < NB; ++b) v = lane == b ? s[b] : v;
            bias[(size_t)lane * N + it] = v; }
        w0 = n0; w1 = n1;
    }
}

#define XB_XCNT(j)  (256  + 64 * (j))
#define XB_XSUB(j)  (1280 + 64 * (j))
#define XB_XGEN(j)  (2304 + 64 * (j))
#define XB_TOP      3328
#define XB_TOPGEN   3392
__device__ __forceinline__ unsigned xb_ld(unsigned* p)              { return __hip_atomic_load(p, __ATOMIC_RELAXED, __HIP_MEMORY_SCOPE_AGENT); }
__device__ __forceinline__ unsigned xb_add(unsigned* p, unsigned v) { return __hip_atomic_fetch_add(p, v, __ATOMIC_RELAXED, __HIP_MEMORY_SCOPE_AGENT); }
__device__ __forceinline__ void grid_bar(unsigned* bar, unsigned x, volatile LAS unsigned* st, unsigned G, int wave) {
    asm volatile("s_waitcnt vmcnt(0) lgkmcnt(0)" ::: "memory");
    __syncthreads();
    if (wave == 0) {
        if (lane_id_asm() == 0) {
            unsigned nloc = st[0], nx = st[1];
            if (nloc == 0u) {
                for (;;) { unsigned sum = 0u, cnt = 0u, mine = 0u;
#pragma unroll
                    for (unsigned jj = 0; jj < 16; ++jj) { const unsigned c = xb_ld(&bar[XB_XCNT(jj)]); sum += c; cnt += (c > 0u) ? 1u : 0u; mine = (jj == x) ? c : mine; }
                    if (sum == G) { nloc = mine; nx = cnt; break; }
                    __builtin_amdgcn_s_sleep(1); }
                st[0] = nloc; st[1] = nx;
            }
            const unsigned old = xb_add(&bar[XB_XSUB(x)], 1u), gen = old / nloc;
            if (old + 1u == (gen + 1u) * nloc) {
                __builtin_amdgcn_fence(__ATOMIC_RELEASE, "agent");
                asm volatile("s_waitcnt vmcnt(0)" ::: "memory");
                const unsigned og = xb_add(&bar[XB_TOP], 1u), tg = og / nx;
                if (og + 1u == (tg + 1u) * nx) xb_add(&bar[XB_TOPGEN], 1u);
                else while (xb_ld(&bar[XB_TOPGEN]) == tg) __builtin_amdgcn_s_sleep(1);
                __builtin_amdgcn_fence(__ATOMIC_ACQUIRE, "agent");
                xb_add(&bar[XB_XGEN(x)], 1u);
                asm volatile("s_waitcnt vmcnt(0)" ::: "memory");
            } else {
                while (xb_ld(&bar[XB_XGEN(x)]) == gen) __builtin_amdgcn_s_sleep(1);
                __builtin_amdgcn_fence(__ATOMIC_ACQUIRE, "agent");
                asm volatile("s_waitcnt vmcnt(0)" ::: "memory");
            }
        }
    }
    __syncthreads();
}
__global__ void __launch_bounds__(512) mega(Args a) {
    extern __shared__ __attribute__((aligned(16))) unsigned char lds[];
    cg::grid_group grid = cg::this_grid();
    LAS unsigned char* L = (LAS unsigned char*)lds;
    const int tid = threadIdx.x, lane = tid & 63, wave = __builtin_amdgcn_readfirstlane(tid >> 6);
    const int G = gridDim.x, bx = blockIdx.x, vcu = (G % 8 == 0) ? (bx % 8) * (G / 8) + bx / 8 : bx;
    const int gw = vcu * 8 + wave, NGW = G * 8;
    unsigned char* ws = a.ws;
    float* mod = (float*)(ws + WS_MOD);
    float* gmt = (float*)(ws + WS_GM);
    pg8::rss_t* rssb = (pg8::rss_t*)(ws + WS_RSS);
    bf16_t* HA = (bf16_t*)(ws + WS_HA); bf16_t* HB = (bf16_t*)(ws + WS_HB); bf16_t* XB = (bf16_t*)(ws + WS_XB);
    unsigned* barw = (unsigned*)(ws + WS_BAR);
    volatile LAS unsigned* bst = (volatile LAS unsigned*)(L + EPI_LDS_OFF + 8192);
    const unsigned xcc = (unsigned)__builtin_amdgcn_s_getreg((3 << 11) | 20) & 0xFu;
    if (tid == 0) { bst[0] = 0u; bst[1] = 0u; (void)xb_add(&barw[XB_XCNT(xcc)], 1u); }
    __syncthreads();
#define GRID_BAR() grid_bar(barw, xcc, bst, (unsigned)G, wave)

    {
        LAS float* sc = (LAS float*)L;
        LAS float* red = sc + NB * 1024;
        for (int e = tid; e < NB * 1024; e += 512) { const float c = e < 1024 ? a.in[2][e] : a.in[3][e - 1024]; sc[e] = c / (1.0f + expf(-c)); }
        __syncthreads();
        for (int it = G - 1 - bx; it < 4 * 96; it += G) {
            const int i = it / 96, cb = it % 96, ks = tid >> 6, cl = tid & 63;
            const float* w = a.in[5] + ((size_t)i * 1024 + ks * 128) * 6144 + cb * 64 + cl;
            float acc[NB];
#pragma unroll
            for (int b = 0; b < NB; ++b) acc[b] = 0.f;
#pragma unroll 16
            for (int k = 0; k < 128; ++k) { const float wv = w[(size_t)k * 6144];
#pragma unroll
                for (int b = 0; b < NB; ++b) acc[b] += sc[b * 1024 + ks * 128 + k] * wv; }
#pragma unroll
            for (int b = 0; b < NB; ++b) red[(ks * NB + b) * 64 + cl] = acc[b];
            __syncthreads();
            for (int e = tid; e < NB * 64; e += 512) { const int b = e >> 6, c2 = e & 63; float s = a.in[6][i * 6144 + cb * 64 + c2];
#pragma unroll
                for (int k2 = 0; k2 < 8; ++k2) s += red[(k2 * NB + b) * 64 + c2];
                mod[((size_t)i * NB + b) * 6144 + cb * 64 + c2] = s; }
            __syncthreads();
        }
        for (int it = bx; it < 128; it += G) ssm_build(a, it >> 6, it & 63, L, ws);
        LAS float* scr = (LAS float*)(L + wave * 16384);
        for (int it = gw; it < 22528; it += NGW) {
            int r = it;
            if (r < 1536) { const int j = r / 768; transpose_item(a.in[7] + (size_t)j * 1024 * 1536, 1024, 1536, (bf16_t*)(ws + WS_WQKV) + (size_t)j * 1536 * 1024, 1, 0, scr, r % 768, lane); continue; } r -= 1536;
            if (r < 1024) { const int j = r / 512; transpose_item(a.in[10] + (size_t)j * 1024 * 1024, 1024, 1024, (bf16_t*)(ws + WS_WO) + (size_t)j * 1024 * 1024, 0, 0, scr, r % 512, lane); continue; } r -= 1024;
            if (r < 1024) { const int j = r / 512; transpose_item(a.in[11] + (size_t)j * 1024 * 1024, 1024, 1024, (bf16_t*)(ws + WS_WIN) + (size_t)j * 1024 * 1024, 0, 0, scr, r % 512, lane); continue; } r -= 1024;
            if (r < 2048) { const int j = r / 1024; transpose_item(a.in[20] + (size_t)j * 1024 * 2048, 1024, 2048, (bf16_t*)(ws + WS_WGLU) + (size_t)j * 2048 * 1024, 2, 1024, scr, r % 1024, lane); continue; } r -= 2048;
            if (r < 11264) { const int j = r / 2816; transpose_item(a.in[21] + (size_t)j * 1024 * 5632, 1024, 5632, (bf16_t*)(ws + WS_WGU) + (size_t)j * 5632 * 1024, 2, 2816, scr, r % 2816, lane); continue; } r -= 11264;
            { const int j = r / 1408; transpose_item(a.in[22] + (size_t)j * 2816 * 1024, 2816, 1024, (bf16_t*)(ws + WS_WDN) + (size_t)j * 1024 * 2816, 0, 0, scr, r % 1408, lane); }
        }
        { f32x4* z = (f32x4*)(ws + WS_RSS); const f32x4 zero = {0.f, 0.f, 0.f, 0.f}; for (int e = bx * 512 + tid; e < 9 * TT / 2; e += G * 512) z[e] = zero; }
    }
    grid.sync();

    {
        for (int e = bx * 512 + tid; e < 4 * 2 * NB * 1024; e += G * 512) { const int c = e & 1023, b = (e >> 10) % NB, iw = e / (NB * 1024), i = iw >> 1, w = iw & 1;
            gmt[e] = a.in[4][(size_t)iw * 1024 + c] * (1.0f + mod[((size_t)i * NB + b) * 6144 + (w ? 4 : 1) * 1024 + c]); }
        {
            for (int ch = gw; ch < 3456; ch += NGW) {
                int r = ch * 8;
                if (r < 3072) { const int j = r / 1536, rr = r % 1536; bias_rows((const bf16_t*)(ws + WS_WQKV) + (size_t)j * 1536 * 1024, 1536, mod + (size_t)(2 * j) * NB * 6144, 0, (float*)(ws + WS_BQKV) + (size_t)j * NB * 1536, rr, rr + 8, lane); continue; } r -= 3072;
                if (r < 2048) { const int j = r / 1024, rr = r % 1024; bias_rows((const bf16_t*)(ws + WS_WIN) + (size_t)j * 1024 * 1024, 1024, mod + (size_t)(2 * j + 1) * NB * 6144, 0, (float*)(ws + WS_BU) + (size_t)j * NB * 1024, rr, rr + 8, lane); continue; } r -= 2048;
                { const int i = r / 5632, rr = r % 5632; bias_rows((const bf16_t*)(ws + WS_WGU) + (size_t)i * 5632 * 1024, 5632, mod + (size_t)i * NB * 6144, 3, (float*)(ws + WS_BGU) + (size_t)i * NB * 5632, rr, rr + 8, lane); }
            }
        }
        init_rows(a, a.in[4], mod, HA, XB, rssb, gw, NGW);
    }
    GRID_BAR();

#pragma unroll 1
    for (int i = 0; i < 4; ++i) {
        const int j = i >> 1;
        const float* modl = mod + (size_t)i * NB * 6144;
        if ((i & 1) == 0) {
            bf16_t* QKV = (bf16_t*)(ws + WS_QKV);
            {
                pg8::Gemm g{HA, (const bf16_t*)(ws + WS_WQKV) + (size_t)j * 1536 * 1024, TT, NQKV, DM, 0, 0, 0}; pg8::Order S; S.init(TT, NQKV, 1, G, bx);
                pg8::EpiQKV E{QKV, a.in[8] + j * 128, a.in[9] + j * 128, (LAS float*)(L + EPI_LDS_OFF), rssb + (size_t)(2 * i) * TT, (const float*)(ws + WS_BQKV) + (size_t)j * NB * 1536};
                pg8::gemm_phase<pg8::EpiQKV, pg8::Order, true, true>(L, g, S, E, wave);
            }
            GRID_BAR();
            {
                int vcu2 = vcu; asm volatile("" : "+s"(vcu2));
                for (int id = vcu2; id < 2560; id += G) {
                    int qh, kv, row0, kvrow0, seq;
                    if (id < 512) { kv = id >> 8; const int rem = id & 255; qh = kv * 4 + (rem >> 6); kvrow0 = 0; row0 = (rem & 63) * 256; seq = LP; }
                    else { const int id2 = id - 512, gg = id2 >> 7, u = id2 & 127; kv = gg & 1; qh = kv * 4 + (u >> 5); kvrow0 = LP + (gg >> 1) * LS; row0 = kvrow0 + (u & 31) * 256; seq = LS; }
                    attn::attn_dense_body<attn::bf16>((const attn::bf16*)QKV + (size_t)row0 * 1536 + qh * 128, (const attn::bf16*)QKV + (size_t)kvrow0 * 1536 + 1024 + kv * 128,
                                                      (const attn::bf16*)QKV + (size_t)kvrow0 * 1536 + 1280 + kv * 128, HB + (size_t)row0 * DM + qh * 128, seq, (char*)lds, wave);
                    __syncthreads();
                }
            }
            GRID_BAR();
            {
                pg8::Gemm g{HB, (const bf16_t*)(ws + WS_WO) + (size_t)j * 1024 * 1024, TT, DM, DM, 0, 0, 0}; pg8::Order S; S.init(TT, DM, 1, G, bx);
                pg8::EpiRes E{XB, modl + 2 * 1024, gmt + (size_t)(2 * i + 1) * NB * 1024, HA, rssb + (size_t)(2 * i + 1) * TT};
            pg8::gemm_phase<pg8::EpiRes, pg8::Order, true, true>(L, g, S, E, wave);
            }
            GRID_BAR();
        } else {
            bf16_t* A2 = (bf16_t*)(ws + WS_A2); float* EE = (float*)(ws + WS_E);
            const bf16_t* SM = (const bf16_t*)(ws + WS_SSM + (size_t)j * 64 * MiB);
            {
                pg8::Gemm g{HA, (const bf16_t*)(ws + WS_WIN) + (size_t)j * 1024 * 1024, TT, DM, DM, 0, 0, 0}; pg8::Order S; S.init(TT, DM, 1, G, bx);
                pg8::EpiU E{A2, rssb + (size_t)(2 * i) * TT, (const float*)(ws + WS_BU) + (size_t)j * NB * 1024};
                pg8::gemm_phase<pg8::EpiU, pg8::Order, true, true>(L, g, S, E, wave);
            }
            GRID_BAR();
            {
                pg8::Gemm g{A2, SM + 512 * 768, NCH, 256, 512, (size_t)NCH * 768 * 2, MiB, 768}; pg8::Order S; S.init(NCH, 256, 64, G, bx);
                pg8::EpiE E{EE};
                pg8::gemm_phase<pg8::EpiE, pg8::Order, true, true>(L, g, S, E, wave);
            }
            GRID_BAR();
            {
                const f32x2* lam32 = (const f32x2*)(ws + WS_LAM);
                const int lane = lane_id_asm();
                int gw2 = gw; asm volatile("" : "+s"(gw2));
                for (int it = gw2; it < NB * 128; it += NGW) {
                    const int seq = it >> 7, rem = it & 127, gg = rem >> 1, dir = rem & 1;
                    const int nc = seq == 0 ? LP / 32 : LS / 32, c0 = seq == 0 ? 0 : LP / 32 + (seq - 1) * (LS / 32);
                    const f32x2 Lm = lam32[((j * 64 + gg) * 2 + dir) * 64 + lane];
                    const float* __restrict__ Eb = EE + ((size_t)gg * NCH + c0) * 256 + dir * 128 + lane;
                    bf16_t* __restrict__ Sb = A2 + ((size_t)gg * NCH + c0) * 768 + 512 + dir * 128 + lane;
                    float sr = 0.f, si = 0.f;
                    const long cs = dir ? -1 : 1; const long cstart = dir ? nc - 1 : 0;
#pragma unroll 1
                    for (int cb = 0; cb < nc; cb += 64) {
                        float er[64], ei[64];
                        const float* ep = Eb + (cstart + cs * cb) * 256; bf16_t* sp = Sb + (cstart + cs * cb) * 768;
#pragma unroll
                        for (int k = 0; k < 64; ++k) { er[k] = ep[cs * k * 256]; ei[k] = ep[cs * k * 256 + 64]; }
                        asm volatile("" ::: "memory");
#pragma unroll
                        for (int k = 0; k < 64; ++k) {
                            sp[cs * k * 768] = (bf16_t)f2bf(sr); sp[cs * k * 768 + 64] = (bf16_t)f2bf(si);
                            const float nr = Lm.x * sr - Lm.y * si + er[k], ni = Lm.x * si + Lm.y * sr + ei[k]; sr = nr; si = ni; }
                    }
                }
            }
            GRID_BAR();
            {
                pg8::Gemm g{A2, SM, NCH, 512, 768, (size_t)NCH * 768 * 2, MiB, 768}; pg8::Order S; S.init(NCH, 512, 64, G, bx);
                pg8::EpiS2 E{HB};
                pg8::gemm_phase<pg8::EpiS2, pg8::Order, true, true>(L, g, S, E, wave);
            }
            GRID_BAR();
            {
                pg8::Gemm g{HB, (const bf16_t*)(ws + WS_WGLU) + (size_t)j * 2048 * 1024, TT, 2048, DM, 0, 0, 0}; pg8::Order S; S.init(TT, 2048, 1, G, bx);
                pg8::EpiGluRes E{XB, modl + 2 * 1024, gmt + (size_t)(2 * i + 1) * NB * 1024, HA, rssb + (size_t)(2 * i + 1) * TT};
            pg8::gemm_phase<pg8::EpiGluRes, pg8::Order, true, true>(L, g, S, E, wave);
            }
            GRID_BAR();
        }
        bf16_t* ACT = (bf16_t*)(ws + WS_ACT);
        {
            pg8::Gemm g{HA, (const bf16_t*)(ws + WS_WGU) + (size_t)i * 5632 * 1024, TT, 5632, DM, 0, 0, 0}; pg8::Order S; S.init(TT, 5632, 1, G, bx);
            pg8::EpiGU E{ACT, rssb + (size_t)(2 * i + 1) * TT, (const float*)(ws + WS_BGU) + (size_t)i * NB * 5632};
            pg8::gemm_phase<pg8::EpiGU, pg8::Order, true, true>(L, g, S, E, wave);
        }
        GRID_BAR();
        {
            pg8::Gemm g{ACT, (const bf16_t*)(ws + WS_WDN) + (size_t)i * 1024 * 2816, TT, DM, DFF, 0, 0, 0}; pg8::Order S; S.init(TT, DM, 1, G, bx);
            pg8::EpiRes E{XB, modl + 5 * 1024, i < 3 ? gmt + (size_t)(2 * i + 2) * NB * 1024 : (const float*)nullptr, HA, rssb + (size_t)(2 * i + 2) * TT};
            pg8::gemm_phase<pg8::EpiRes, pg8::Order, true, true>(L, g, S, E, wave);
        }
        GRID_BAR();
    }
    { const int lane = lane_id_asm(), fr = lane & 15, fq = lane >> 4; const pg8::rss_t* rs8 = rssb + (size_t)8 * TT;
    for (int gi = gw; gi < TT / 16; gi += NGW) {
        const int row = gi * 16 + fr, pm = gi >> 4, am = ((gi >> 3) & 1) * 4 + (gi & 3), wr = (gi >> 2) & 1;
        const float rstd = 1.0f / sqrtf((float)rs8[row] * (1.0f / (1048576.0f * DM)) + EPS);
#pragma unroll 1
        for (int ib = 0; ib < 32; ib += 8) {
            pg8::u32x4 w[8]; f32x4 g0[8], g1[8];
#pragma unroll
            for (int k = 0; k < 8; ++k) { const int it = ib + k, pnq = it >> 2, wc = it & 3, c0 = pnq * 128 + wc * 32 + fq * 8;
                w[k] = *(const pg8::u32x4*)(XB + ((size_t)((((pm * 8 + pnq) * 2 + wr) * 4 + wc) * 8 + am) * 64 + lane) * 8);
                g0[k] = *(const f32x4*)(a.in[23] + c0); g1[k] = *(const f32x4*)(a.in[23] + c0 + 4); }
            asm volatile("" ::: "memory");
#pragma unroll
            for (int k = 0; k < 8; ++k) { const int it = ib + k, pnq = it >> 2, wc = it & 3, c0 = pnq * 128 + wc * 32 + fq * 8;
                f32x4 v0, v1; pg8::bf8_to_f32(w[k], v0, v1);
                __builtin_nontemporal_store((v0 * rstd) * g0[k], (f32x4*)(a.out + (size_t)row * DM + c0)); __builtin_nontemporal_store((v1 * rstd) * g1[k], (f32x4*)(a.out + (size_t)row * DM + c0 + 4)); }
        }
    }
    }
}

extern "C" void kernel_launch(void* const* d_in, const int* in_sizes, int n_in, void* d_out, int out_size, void* d_ws, size_t ws_size, hipStream_t stream) {
    static int grid = 0;
    if (grid == 0) {
        if (n_in != 24 || out_size != TT * DM || ws_size < WS_NEED) { fprintf(stderr, "kernel_launch: unexpected shapes: n_in %d out %d ws %zu (need %zu)\n", n_in, out_size, ws_size, (size_t)WS_NEED); grid = -1; return; }
        int dev = 0, cus = 0, per_cu = 0;
        if (hipGetDevice(&dev) != hipSuccess || hipDeviceGetAttribute(&cus, hipDeviceAttributeMultiprocessorCount, dev) != hipSuccess) { grid = -1; return; }
        if (hipFuncSetAttribute((const void*)mega, hipFuncAttributeMaxDynamicSharedMemorySize, LDS_BYTES) != hipSuccess) { fprintf(stderr, "kernel_launch: hipFuncSetAttribute failed\n"); grid = -1; return; }
        if (hipOccupancyMaxActiveBlocksPerMultiprocessor(&per_cu, (const void*)mega, 512, LDS_BYTES) != hipSuccess || per_cu < 1) { fprintf(stderr, "kernel_launch: occupancy query says %d\n", per_cu); (void)hipGetLastError(); }
        grid = cus;
    }
    if (grid < 0) return;
    if (hipMemsetAsync((char*)d_ws + WS_BAR, 0, 16384, stream) != hipSuccess) { fprintf(stderr, "kernel_launch: memset failed\n"); return; }
    Args a{};
    for (int i = 0; i < 24; ++i) a.in[i] = (const float*)d_in[i];
    a.out = (float*)d_out; a.ws = (unsigned char*)d_ws;
    void* args[] = {&a};
    hipError_t e = hipLaunchCooperativeKernel((const void*)mega, dim3(grid), dim3(512), args, LDS_BYTES, stream);
    if (e != hipSuccess) fprintf(stderr, "cooperative launch failed: %s (grid %d)\n", hipGetErrorString(e), grid);
}
```
